# Optimizing an MI355X kernel written in HIP

```python
import math
import jax, jax.numpy as jnp
from jax import lax
import numpy as np

D_MODEL = 2048
BATCH = 4
SEQ = 4096
DEPTH = 2

CHUNK = 64
MEM_LEN = 256
ROPE_THETA = 10000.0
NORM_EPS = 1e-6

RET_HEADS = 4
RET_QK_DIM = 256
RET_V_DIM = 512
SG_GROUPS = 4
SG_DIM = 256
SG_BLOCK = 128
DIFF_HEADS = 8
DIFF_HEAD_DIM = 128
Q_BLOCK = 128
XA_HEADS = 4
XA_HEAD_DIM = D_MODEL // XA_HEADS
D_FF = 4 * D_MODEL

N_EVEN = (DEPTH + 1) // 2
N_ODD = DEPTH // 2

RET_W = RET_HEADS * RET_QK_DIM
RET_VW = RET_HEADS * RET_V_DIM
SG_W = SG_GROUPS * SG_DIM
EVEN_IN = 2 * RET_W + 2 * RET_VW + 2 * SG_W
EVEN_OUT = RET_VW + SG_W
DIFF_QK_W = DIFF_HEADS * 2 * DIFF_HEAD_DIM
DIFF_V_W = DIFF_HEADS * 2 * DIFF_HEAD_DIM

kernel_name = 'chunk_causal_hybrid_retention_sgmlp_diffattn'


def rms_norm(x, gain):
    xf = x.astype(jnp.float32)
    y = xf * lax.rsqrt(jnp.mean(xf * xf, axis=-1, keepdims=True) + NORM_EPS)
    return (y * gain.astype(jnp.float32)).astype(x.dtype)


def rope_tables(positions, dim):
    inv = ROPE_THETA ** (-jnp.arange(0, dim, 2, dtype=jnp.float32) / dim)
    ang = positions.astype(jnp.float32)[..., None] * inv
    return jnp.cos(ang), jnp.sin(ang)


def apply_rope(x, cos, sin):
    half = x.shape[-1] // 2
    x1, x2 = x[..., :half], x[..., half:]
    c = cos.astype(x.dtype)
    s = sin.astype(x.dtype)
    return jnp.concatenate([x1 * c - x2 * s, x2 * c + x1 * s], axis=-1)


def split_heads(t, h):
    b, s, w = t.shape
    return t.reshape(b, s, h, w // h).transpose(0, 2, 1, 3)


def merge_heads(t):
    b, h, s, d = t.shape
    return t.transpose(0, 2, 1, 3).reshape(b, s, h * d)


def retention(q, k, v):
    out_dtype = v.dtype
    q = q.astype(jnp.float32)
    k = k.astype(jnp.float32)
    v = v.astype(jnp.float32)
    b, h, s, dk = q.shape
    dv = v.shape[-1]
    nc = s // CHUNK
    log_g = jnp.log(1.0 - 2.0 ** (-5.0 - jnp.arange(h, dtype=jnp.float32)))
    idx = jnp.arange(CHUNK, dtype=jnp.float32)
    intra = jnp.exp(log_g[:, None, None] * jnp.abs(idx[:, None] - idx[None, :]))
    q_decay = jnp.exp(log_g[:, None] * idx)[..., None]
    k_decay = jnp.exp(log_g[:, None] * (CHUNK - idx))[..., None]
    chunk_decay = jnp.exp(log_g * CHUNK)[:, None, None]

    def to_chunks(t):
        return t.reshape(b, h, nc, CHUNK, t.shape[-1]).transpose(2, 0, 1, 3, 4)

    def step(state, inp):
        qc, kc, vc = inp
        scores = jnp.einsum('bhid,bhjd->bhij', qc, kc) * intra
        out = (jnp.einsum('bhij,bhje->bhie', scores, vc)
               + jnp.einsum('bhid,bhde->bhie', qc * q_decay, state))
        state = state * chunk_decay + jnp.einsum('bhjd,bhje->bhde', kc * k_decay, vc)
        return state, out

    init = jnp.zeros((b, h, dk, dv), jnp.float32)
    _, outs = lax.scan(step, init, (to_chunks(q), to_chunks(k), to_chunks(v)))
    return outs.transpose(1, 2, 0, 3, 4).reshape(b, h, s, dv).astype(out_dtype)


def spatial_gate(u, v, w_s, b_s):
    b, s, g, dg = v.shape
    nb = s // SG_BLOCK
    vb = v.reshape(b, nb, SG_BLOCK, g, dg)
    pos_chunk = jnp.arange(SG_BLOCK) // CHUNK
    mask = pos_chunk[None, :] <= pos_chunk[:, None]
    w = jnp.where(mask[None], w_s, jnp.zeros_like(w_s))
    mixed = jnp.einsum('gij,bnjgc->bnigc', w, vb) + b_s.T[None, None, :, :, None]
    return u * mixed.reshape(b, s, g, dg)


def even_mixer(h, cos_r, sin_r, w_in, ret_gain, sg_norm_gain, sg_w, sg_b, w_out):
    b, s, _ = h.shape
    proj = h @ w_in
    cuts = [RET_W, 2 * RET_W, 2 * RET_W + RET_VW, 2 * RET_W + 2 * RET_VW, 2 * RET_W + 2 * RET_VW + SG_W]
    q, k, v, g, u, vs = jnp.split(proj, cuts, axis=-1)
    c = cos_r[:, None]
    sn = sin_r[:, None]
    q = apply_rope(split_heads(q, RET_HEADS), c, sn)
    k = apply_rope(split_heads(k, RET_HEADS), c, sn) * (RET_QK_DIM ** -0.5)
    ret = retention(q, k, split_heads(v, RET_HEADS))
    ret = rms_norm(ret.transpose(0, 2, 1, 3), ret_gain).reshape(b, s, RET_VW)
    out_a = jax.nn.silu(g) * ret
    u = jax.nn.gelu(u).reshape(b, s, SG_GROUPS, SG_DIM)
    vs = rms_norm(jax.nn.gelu(vs).reshape(b, s, SG_GROUPS, SG_DIM), sg_norm_gain)
    out_b = spatial_gate(u, vs, sg_w, sg_b).reshape(b, s, SG_W)
    return jnp.concatenate([out_a, out_b], axis=-1) @ w_out


def diff_attention(h, cos_d, sin_d, w_qkv, q_gain, k_gain, lam_q1, lam_k1, lam_q2, lam_k2,
                   sub_gain, w_o, lambda_init):
    b, s, _ = h.shape
    proj = h @ w_qkv
    q, k, v = jnp.split(proj, [DIFF_QK_W, 2 * DIFF_QK_W], axis=-1)
    q = q.reshape(b, s, DIFF_HEADS, 2, DIFF_HEAD_DIM).transpose(0, 2, 3, 1, 4)
    k = k.reshape(b, s, DIFF_HEADS, 2, DIFF_HEAD_DIM).transpose(0, 2, 3, 1, 4)
    v = split_heads(v, DIFF_HEADS)
    c = cos_d[:, None, None]
    sn = sin_d[:, None, None]
    q = apply_rope(rms_norm(q, q_gain), c, sn) * (DIFF_HEAD_DIM ** -0.5)
    k = apply_rope(rms_norm(k, k_gain), c, sn)
    lam = (jnp.exp(jnp.sum(lam_q1.astype(jnp.float32) * lam_k1.astype(jnp.float32)))
           - jnp.exp(jnp.sum(lam_q2.astype(jnp.float32) * lam_k2.astype(jnp.float32)))
           + lambda_init)
    nqb = s // Q_BLOCK
    qb = q.reshape(b, DIFF_HEADS, 2, nqb, Q_BLOCK, DIFF_HEAD_DIM).transpose(3, 0, 1, 2, 4, 5)
    key_chunk = jnp.arange(s) // CHUNK
    q_off = jnp.arange(nqb) * Q_BLOCK

    def block(args):
        qblk, off = args
        q_chunk = (off + jnp.arange(Q_BLOCK)) // CHUNK
        mask = key_chunk[None, :] <= q_chunk[:, None]
        sc = jnp.einsum('bhmqd,bhmkd->bhmqk', qblk, k).astype(jnp.float32)
        sc = jnp.where(mask, sc, jnp.float32(-1e30))
        p = jax.nn.softmax(sc, axis=-1)
        attn = p[:, :, 0] - lam * p[:, :, 1]
        return jnp.einsum('bhqk,bhke->bhqe', attn.astype(v.dtype), v)

    out = lax.map(block, (qb, q_off))
    out = out.transpose(1, 0, 3, 2, 4).reshape(b, s, DIFF_HEADS, 2 * DIFF_HEAD_DIM)
    out = rms_norm(out, sub_gain) * (1.0 - lambda_init)
    return out.reshape(b, s, DIFF_V_W) @ w_o


def memory_cross_attention(h, mem_n, w_q, w_kv, q_gain, k_gain, w_o):
    q = split_heads(h @ w_q, XA_HEADS)
    k, v = jnp.split(mem_n @ w_kv, 2, axis=-1)
    k = rms_norm(split_heads(k, XA_HEADS), k_gain)
    v = split_heads(v, XA_HEADS)
    q = rms_norm(q, q_gain) * (XA_HEAD_DIM ** -0.5)
    sc = jnp.einsum('bhqd,bhkd->bhqk', q, k).astype(jnp.float32)
    p = jax.nn.softmax(sc, axis=-1).astype(v.dtype)
    return merge_heads(jnp.einsum('bhqk,bhkd->bhqd', p, v)) @ w_o


def squared_relu_mlp(h, w1, w2):
    a = jax.nn.relu(h @ w1)
    return (a * a) @ w2


def setup_inputs(seed: int = 0) -> dict:
    key = jax.random.key(seed)
    ks = iter(jax.random.split(key, 48))

    def nrm(shape, scale):
        return jax.random.normal(next(ks), shape, jnp.float32) * scale

    def gain(shape):
        return 1.0 + 0.02 * jax.random.normal(next(ks), shape, jnp.float32)

    D = D_MODEL
    x = nrm((BATCH, SEQ, D), 1.0)
    mem = nrm((BATCH, MEM_LEN, D), 1.0)
    offset = jax.random.randint(next(ks), (BATCH, 1), 0, 64, dtype=jnp.int32) * CHUNK
    positions = (offset + jnp.arange(SEQ, dtype=jnp.int32)[None, :]).astype(jnp.int32)
    return {
        'x': x,
        'mem': mem,
        'positions': positions,
        'norm_mix': gain((DEPTH, D)),
        'norm_xa': gain((DEPTH, D)),
        'norm_mem': gain((DEPTH, D)),
        'norm_ffn': gain((DEPTH, D)),
        'ev_w_in': nrm((N_EVEN, D, EVEN_IN), D ** -0.5),
        'ev_ret_gain': gain((N_EVEN, RET_HEADS, RET_V_DIM)),
        'ev_sg_norm': gain((N_EVEN, SG_GROUPS, SG_DIM)),
        'ev_sg_w': nrm((N_EVEN, SG_GROUPS, SG_BLOCK, SG_BLOCK), SG_BLOCK ** -0.5),
        'ev_sg_b': 1.0 + nrm((N_EVEN, SG_GROUPS, SG_BLOCK), 0.01),
        'ev_w_out': nrm((N_EVEN, EVEN_OUT, D), EVEN_OUT ** -0.5),
        'od_w_qkv': nrm((N_ODD, D, 2 * DIFF_QK_W + DIFF_V_W), D ** -0.5),
        'od_q_gain': gain((N_ODD, DIFF_HEAD_DIM)),
        'od_k_gain': gain((N_ODD, DIFF_HEAD_DIM)),
        'od_lam_q1': nrm((N_ODD, DIFF_HEAD_DIM), 0.1),
        'od_lam_k1': nrm((N_ODD, DIFF_HEAD_DIM), 0.1),
        'od_lam_q2': nrm((N_ODD, DIFF_HEAD_DIM), 0.1),
        'od_lam_k2': nrm((N_ODD, DIFF_HEAD_DIM), 0.1),
        'od_sub_gain': gain((N_ODD, 2 * DIFF_HEAD_DIM)),
        'od_w_o': nrm((N_ODD, DIFF_V_W, D), DIFF_V_W ** -0.5),
        'xa_w_q': nrm((DEPTH, D, D), D ** -0.5),
        'xa_w_kv': nrm((DEPTH, D, 2 * D), D ** -0.5),
        'xa_q_gain': gain((DEPTH, XA_HEAD_DIM)),
        'xa_k_gain': gain((DEPTH, XA_HEAD_DIM)),
        'xa_w_o': nrm((DEPTH, D, D), D ** -0.5),
        'ffn_w1': nrm((DEPTH, D, D_FF), D ** -0.5),
        'ffn_w2': nrm((DEPTH, D_FF, D), D_FF ** -0.5),
    }


def reference(x, mem, positions, norm_mix, norm_xa, norm_mem, norm_ffn,
              ev_w_in, ev_ret_gain, ev_sg_norm, ev_sg_w, ev_sg_b, ev_w_out,
              od_w_qkv, od_q_gain, od_k_gain, od_lam_q1, od_lam_k1, od_lam_q2, od_lam_k2,
              od_sub_gain, od_w_o,
              xa_w_q, xa_w_kv, xa_q_gain, xa_k_gain, xa_w_o,
              ffn_w1, ffn_w2):
    cos_r, sin_r = rope_tables(positions, RET_QK_DIM)
    cos_d, sin_d = rope_tables(positions, DIFF_HEAD_DIM)
    for li in range(DEPTH):
        h = rms_norm(x, norm_mix[li])
        if li % 2 == 0:
            e = li // 2
            x = x + even_mixer(h, cos_r, sin_r, ev_w_in[e], ev_ret_gain[e], ev_sg_norm[e],
                               ev_sg_w[e], ev_sg_b[e], ev_w_out[e])
        else:
            o = li // 2
            lambda_init = 0.8 - 0.6 * math.exp(-0.3 * li)
            x = x + diff_attention(h, cos_d, sin_d, od_w_qkv[o], od_q_gain[o], od_k_gain[o],
                                   od_lam_q1[o], od_lam_k1[o], od_lam_q2[o], od_lam_k2[o],
                                   od_sub_gain[o], od_w_o[o], lambda_init)
        x = x + memory_cross_attention(rms_norm(x, norm_xa[li]), rms_norm(mem, norm_mem[li]),
                                       xa_w_q[li], xa_w_kv[li], xa_q_gain[li], xa_k_gain[li],
                                       xa_w_o[li])
        x = x + squared_relu_mlp(rms_norm(x, norm_ffn[li]), ffn_w1[li], ffn_w2[li])
    return x
```

```cpp
#include <hip/hip_runtime.h>
#include <hip/hip_cooperative_groups.h>
#include <cstdio>
#include <cstdint>
namespace cg = cooperative_groups;

#ifndef CHK
#define CHK 0
#endif
#ifndef CHKALT
#define CHKALT 0
#endif
#ifndef RETPART
#define RETPART 0
#endif
#ifndef DBL_GEMM
#define DBL_GEMM 0
#endif
#ifndef DBL_ATT
#define DBL_ATT 0
#endif
#ifndef DBL_RET
#define DBL_RET 0
#endif
#ifndef DBL_CVT
#define DBL_CVT 0
#endif
#ifndef DBL_MISC
#define DBL_MISC 0
#endif
#ifndef RET_NAIVE
#define RET_NAIVE 0
#endif
#ifndef NAIVE_SRC
#define NAIVE_SRC 0
#endif
#ifndef ABL_SG
#define ABL_SG 0
#endif
#ifndef ABL_RET
#define ABL_RET 0
#endif
#ifndef ABL_XA
#define ABL_XA 0
#endif
#ifndef ABL_DIFF
#define ABL_DIFF 0
#endif
#define LAS __attribute__((address_space(3)))
typedef unsigned short bf16_t;
typedef short bf16x8 __attribute__((ext_vector_type(8)));
typedef short s16x4 __attribute__((ext_vector_type(4)));
typedef float f32x2 __attribute__((ext_vector_type(2)));
typedef float f32x4 __attribute__((ext_vector_type(4)));
typedef float f32x16 __attribute__((ext_vector_type(16)));
typedef unsigned u32x2 __attribute__((ext_vector_type(2)));
typedef unsigned u32x4 __attribute__((ext_vector_type(4)));

constexpr int T_TOK = 16384, DM = 2048, SEQ = 4096, NB = 4;
constexpr float EPS = 1e-6f;
constexpr float LOG2_THETA = 13.287712379549449f;
constexpr int NTHR = 512;
constexpr int LDS_BYTES = 155648;

constexpr size_t MiB = 1048576;
constexpr size_t OFF_W = 0;
constexpr size_t OFF_A1 = 140 * MiB;
constexpr size_t OFF_A2 = 396 * MiB;
constexpr size_t OFF_A3 = 492 * MiB;
constexpr size_t OFF_KVX = 556 * MiB;
constexpr size_t OFF_XVT = 564 * MiB;
constexpr size_t OFF_MEMN = 568 * MiB;
constexpr size_t OFF_SSQ = 572 * MiB;
constexpr size_t OFF_KT = 576 * MiB;
constexpr size_t OFF_RET = 608 * MiB;
constexpr size_t OFF_XS = 576 * MiB;
constexpr size_t OFF_W2KV = OFF_A1;
constexpr size_t OFF_MEMN2 = OFF_A1 + 16 * MiB;
constexpr size_t OFF_KVX2 = 640 * MiB;
constexpr size_t OFF_XVT2 = 648 * MiB;
constexpr size_t WS_END = 652 * MiB;

constexpr size_t W0_IN = 0;
constexpr size_t W0_OUT = W0_IN + (size_t)8192 * 2048;
constexpr size_t W0_XQ = W0_OUT + (size_t)2048 * 3072;
constexpr size_t W0_XKV = W0_XQ + (size_t)2048 * 2048;
constexpr size_t W0_XO = W0_XKV + (size_t)4096 * 2048;
constexpr size_t W0_F1 = W0_XO + (size_t)2048 * 2048;
constexpr size_t W0_F2 = W0_F1 + (size_t)8192 * 2048;
constexpr size_t W1_QKV = 0;
constexpr size_t W1_O = W1_QKV + (size_t)6144 * 2048;
constexpr size_t W1_XQ = W1_O + (size_t)2048 * 2048;
constexpr size_t W1_XKV = W1_XQ + (size_t)2048 * 2048;
constexpr size_t W1_XO = W1_XKV + (size_t)4096 * 2048;
constexpr size_t W1_F1 = W1_XO + (size_t)2048 * 2048;
constexpr size_t W1_F2 = W1_F1 + (size_t)8192 * 2048;

__device__ __forceinline__ unsigned cvt_pk_bf16(float lo, float hi) { unsigned r; asm("v_cvt_pk_bf16_f32 %0, %1, %2" : "=v"(r) : "v"(lo), "v"(hi)); return r; }
__device__ __forceinline__ float bf_lo(unsigned w) { return __uint_as_float(w << 16); }
__device__ __forceinline__ float bf_hi(unsigned w) { return __uint_as_float(w & 0xffff0000u); }
__device__ __forceinline__ bf16_t f2bf(float f) { return (bf16_t)(cvt_pk_bf16(f, 0.f) & 0xffffu); }
__device__ __forceinline__ float bf2f(bf16_t h) { return __uint_as_float(((unsigned)h) << 16); }
__device__ __forceinline__ void unpack8(u32x4 w, float* f) { f[0] = bf_lo(w.x); f[1] = bf_hi(w.x); f[2] = bf_lo(w.y); f[3] = bf_hi(w.y); f[4] = bf_lo(w.z); f[5] = bf_hi(w.z); f[6] = bf_lo(w.w); f[7] = bf_hi(w.w); }
__device__ __forceinline__ u32x4 pack8(const float* f) { u32x4 w; w.x = cvt_pk_bf16(f[0], f[1]); w.y = cvt_pk_bf16(f[2], f[3]); w.z = cvt_pk_bf16(f[4], f[5]); w.w = cvt_pk_bf16(f[6], f[7]); return w; }
__device__ __forceinline__ float wave_sum(float v) { v += __shfl_xor(v, 32); v += __shfl_xor(v, 16); v += __shfl_xor(v, 8); v += __shfl_xor(v, 4); v += __shfl_xor(v, 2); v += __shfl_xor(v, 1); return v; }
__device__ __forceinline__ float gelu_tanh(float x) { const float u = 0.7978845608028654f * (x + 0.044715f * x * x * x); const float t = 1.f - 2.f / (1.f + __expf(2.f * u)); return 0.5f * x * (1.f + t); }
__device__ __forceinline__ void fast_sincos(float ang, float* s, float* c) { float t = ang * 0.15915494309189535f; t -= rintf(t); *s = __builtin_amdgcn_sinf(t); *c = __builtin_amdgcn_cosf(t); }
__device__ __forceinline__ f32x4 mfma16(bf16x8 a, bf16x8 b, f32x4 c) { return __builtin_amdgcn_mfma_f32_16x16x32_bf16(a, b, c, 0, 0, 0); }
__device__ __forceinline__ int opaque_tid_(int wave_s) { int t; asm volatile("v_mbcnt_lo_u32_b32 %0, -1, 0\n\tv_mbcnt_hi_u32_b32 %0, -1, %0\n\tv_lshl_or_b32 %0, %1, 6, %0" : "=&v"(t) : "s"(wave_s)); return t; }
#define opaque_tid() opaque_tid_(WAVE_S)
__device__ __forceinline__ bf16x8 ldfrag(LAS unsigned char* base, int row, int stride, int kbyte) { return *(LAS bf16x8*)(base + row * stride + kbyte); }

namespace pg8 {
constexpr int BM = 256, BK = 64, HALF = 128, HTB = HALF * BK * 2, STAGE_BYTES = 8 * HTB, NXCD = 8, WGM = 8;
__host__ __device__ __forceinline__ int lds_byte(int r, int c) { const int st = (r >> 4) * 2 + (c >> 5), rr = r & 15, cc = c & 31, ob = rr * 64 + cc * 2; return st * 1024 + (ob ^ (((ob >> 9) & 1) << 5)); }
__host__ __device__ __forceinline__ void stage_rc(int b, int& R, int& C) { const int st = b / 1024, sb = b % 1024, swz = sb ^ (((sb >> 9) & 1) << 5); R = (st >> 1) * 16 + swz / 64; C = (st & 1) * 32 + (swz % 64) / 2; }
__host__ __device__ __forceinline__ int perm32(int rho) { const int n = rho >> 4, i = rho & 15; return 8 * (i >> 2) + 4 * n + (i & 3); }
struct Unit { int pm, pn; };
struct Gemm { const bf16_t* A; const bf16_t* Bt; int M, N, K; };
struct StaticOrder {
    int nM, nN, nwg, G, c;
    __device__ void init(int M, int N, int G_, int c_) { nM = M / BM; nN = N / BM; nwg = nM * nN; G = G_; c = c_; }
    __device__ bool next(int i, Unit& u) const {
        const long L = (long)i * G + c; if (L >= nwg) return false;
        int wgid = (int)L; { const int q = nwg / NXCD, r = nwg % NXCD, xcd = wgid % NXCD, off = wgid / NXCD; wgid = (xcd < r ? xcd * (q + 1) : r * (q + 1) + (xcd - r) * q) + off; }
        const int nig = WGM * nN, gid = wgid / nig, fm = gid * WGM, gsz = (nM - fm) < WGM ? (nM - fm) : WGM;
        u.pm = fm + ((wgid % nig) % gsz); u.pn = (wgid % nig) / gsz; return true;
    }
    __device__ __forceinline__ void a_ready(const Unit&) const {}
    __device__ __forceinline__ void done(const Unit&) const {}
};
__device__ __forceinline__ float ssq_read(const float* p) { return __hip_atomic_load((float*)p, __ATOMIC_RELAXED, __HIP_MEMORY_SCOPE_AGENT); }
template <int ACT  > struct EpiBf16 {
    static constexpr bool PERM = true;
    bf16_t* O; int ldc; const float* ssq;
    __device__ __forceinline__ void operator()(const f32x4 (&acc)[2][2][4][2], const Unit& u, int wr, int wc, int fr, int fq) const {
        const int row0 = u.pm * BM + wr * 64 + fr; const int col0 = u.pn * BM + wc * 32 + 8 * fq;
#pragma unroll
        for (int ai = 0; ai < 2; ++ai)
#pragma unroll
            for (int m = 0; m < 4; ++m) { bf16_t* rowp = O + (size_t)(row0 + ai * HALF + m * 16) * ldc + col0;
                const float rs = ssq ? rsqrtf(ssq_read(ssq + row0 + ai * HALF + m * 16) * (1.f / 2048.f) + EPS) : 1.f;
#pragma unroll
                for (int bj = 0; bj < 2; ++bj) { f32x4 v0 = acc[ai][bj][m][0] * rs, v1 = acc[ai][bj][m][1] * rs;
                    if (ACT == 1) {
#pragma unroll
                        for (int j = 0; j < 4; ++j) { float a = fmaxf(v0[j], 0.f), b = fmaxf(v1[j], 0.f); v0[j] = a * a; v1[j] = b * b; } }
                    u32x4 w; w.x = cvt_pk_bf16(v0[0], v0[1]); w.y = cvt_pk_bf16(v0[2], v0[3]); w.z = cvt_pk_bf16(v1[0], v1[1]); w.w = cvt_pk_bf16(v1[2], v1[3]);
                    *(u32x4*)(rowp + bj * HALF) = w; } }
    }
};
template <int MODE> struct EpiStream {
    static constexpr bool PERM = false;
    const float* Xin; bf16_t* XS; float* ssq; float* Out; int ldc;
    __device__ __forceinline__ void operator()(const f32x4 (&acc)[2][2][4][2], const Unit& u, int wr, int wc, int fr, int fq) const {
        const int row0 = u.pm * BM + wr * 64 + fr, col0 = u.pn * BM + wc * 32 + 4 * fq;
#pragma unroll
        for (int ai = 0; ai < 2; ++ai)
#pragma unroll
            for (int m = 0; m < 4; ++m) { const size_t roff = (size_t)(row0 + ai * HALF + m * 16) * ldc + col0; float ss = 0.f;
#pragma unroll
                for (int bj = 0; bj < 2; ++bj)
#pragma unroll
                    for (int n = 0; n < 2; ++n) { const size_t o = roff + bj * HALF + n * 16; f32x4 v;
                        if (MODE == 0) v = *(const f32x4*)(Xin + o);
                        else { const u32x2 xw = *(const u32x2*)(XS + o); v = (f32x4){bf_lo(xw.x), bf_hi(xw.x), bf_lo(xw.y), bf_hi(xw.y)}; }
                        v = v + acc[ai][bj][m][n];
                        if (MODE == 2) *(f32x4*)(Out + o) = v;
                        else { ss += v[0] * v[0] + v[1] * v[1] + v[2] * v[2] + v[3] * v[3];
                            u32x2 w; w.x = cvt_pk_bf16(v[0], v[1]); w.y = cvt_pk_bf16(v[2], v[3]); *(u32x2*)(XS + o) = w; } }
                if (MODE != 2) { ss += __shfl_xor(ss, 16); ss += __shfl_xor(ss, 32);
                    if (fq == 0) atomicAdd(ssq + row0 + ai * HALF + m * 16, ss); }
                asm volatile("" ::: "memory"); }
    }
};
struct EpiResF32 {
    static constexpr bool PERM = false;
    float* C; int ldc;
    __device__ __forceinline__ void operator()(const f32x4 (&acc)[2][2][4][2], const Unit& u, int wr, int wc, int fr, int fq) const {
        const int row0 = u.pm * BM + wr * 64 + fr, col0 = u.pn * BM + wc * 32 + 4 * fq;
#pragma unroll
        for (int ai = 0; ai < 2; ++ai)
#pragma unroll
            for (int m = 0; m < 4; ++m) { float* rowp = C + (size_t)(row0 + ai * HALF + m * 16) * ldc + col0;
#pragma unroll
                for (int bj = 0; bj < 2; ++bj)
#pragma unroll
                    for (int n = 0; n < 2; ++n) { f32x4* p = (f32x4*)(rowp + bj * HALF + n * 16); *p = *p + acc[ai][bj][m][n]; }
                asm volatile("" ::: "memory"); }
    }
};

template <class Epi, class Sched>
__device__ __forceinline__ void gemm_phase(int WAVE_S, LAS unsigned char* lds, const Gemm g, const Sched& S, const Epi& E) {
    const int tid = opaque_tid(), wid = __builtin_amdgcn_readfirstlane(tid >> 6), lane = tid & 63, wr = wid >> 2, wc = wid & 3, fr = lane & 15, fq = lane >> 4;
    const int K = g.K, nt = K / BK;
    unsigned voffA[2], voffB[2];
#pragma unroll
    for (int i = 0; i < 2; ++i) { int R, C; stage_rc(tid * 16 + i * 8192, R, C); const int Rb = Epi::PERM ? ((R & ~31) + perm32(R & 31)) : R;
        voffA[i] = (unsigned)(R * K + C) * 2u; voffB[i] = (unsigned)(Rb * K + C) * 2u; }
    const size_t kstep = (size_t)(BK * 2);
    const size_t hstep = (size_t)HALF * K * 2;
    const size_t tstep = 2 * hstep;
    const unsigned ldsw = (unsigned)wid * 1024u;
    const int aoff = lds_byte(wr * 64 + fr, fq * 8), boff = lds_byte(wc * 32 + fr, fq * 8);
#define PG8_SA(b, h) (((b) * 2 + (h)) * HTB)
#define PG8_SB(b, h) ((4 + (b) * 2 + (h)) * HTB)
#define PG8_STAGE(bufoff, gbase, voff) do { _Pragma("unroll") for (int _i = 0; _i < 2; ++_i) \
        __builtin_amdgcn_global_load_lds((const unsigned*)((const char*)(gbase) + (voff)[_i]), (LAS unsigned*)(lds + (bufoff) + ldsw + _i * 8192), 16, 0, 0); } while (0)
#define PG8_LDA(dst, b, h) do { _Pragma("unroll") for (int m = 0; m < 4; ++m) _Pragma("unroll") for (int k = 0; k < 2; ++k) dst[m][k] = *(const LAS bf16x8*)(lds + PG8_SA(b, h) + aoff + m * 2048 + k * 1024); } while (0)
#define PG8_LDB(dst, b, h) do { _Pragma("unroll") for (int n = 0; n < 2; ++n) _Pragma("unroll") for (int k = 0; k < 2; ++k) dst[n][k] = *(const LAS bf16x8*)(lds + PG8_SB(b, h) + boff + n * 2048 + k * 1024); } while (0)
#define PG8_MMA(ai, bj, At, Bt) do { __builtin_amdgcn_s_setprio(1); _Pragma("unroll") for (int m = 0; m < 4; ++m) _Pragma("unroll") for (int n = 0; n < 2; ++n) _Pragma("unroll") for (int k = 0; k < 2; ++k) \
        acc[ai][bj][m][n] = __builtin_amdgcn_mfma_f32_16x16x32_bf16(Bt[n][k], At[m][k], acc[ai][bj][m][n], 0, 0, 0); __builtin_amdgcn_s_setprio(0); } while (0)
#define PG8_WAIT_V(n) asm volatile("s_waitcnt vmcnt(" #n ")" ::: "memory")
#define PG8_WAIT_L(n) asm volatile("s_waitcnt lgkmcnt(" #n ")" ::: "memory")
#define PG8_BAR __builtin_amdgcn_s_barrier()
#define PG8_SCHED __builtin_amdgcn_sched_barrier(0)
    Unit cur, nxt; int ui = 0;
    if (!S.next(0, cur)) return;
    f32x4 acc[2][2][4][2];
#pragma unroll
    for (int a = 0; a < 2; ++a)
#pragma unroll
        for (int b = 0; b < 2; ++b)
#pragma unroll
            for (int m = 0; m < 4; ++m)
#pragma unroll
                for (int n = 0; n < 2; ++n) acc[a][b][m][n] = (f32x4){0.f, 0.f, 0.f, 0.f};
    bf16x8 At[4][2], B0[2][2], B1[2][2];
    const char* cA = (const char*)g.A + (size_t)cur.pm * tstep; const char* cB = (const char*)g.Bt + (size_t)cur.pn * tstep;
    S.a_ready(cur);
    PG8_STAGE(PG8_SB(0, 0), cB, voffB); PG8_STAGE(PG8_SA(0, 0), cA, voffA); PG8_STAGE(PG8_SB(0, 1), cB + hstep, voffB); PG8_STAGE(PG8_SA(0, 1), cA + hstep, voffA);
    if (wr == 1) PG8_BAR;
    PG8_WAIT_V(4); PG8_BAR;
    PG8_STAGE(PG8_SB(1, 0), cB + kstep, voffB); PG8_STAGE(PG8_SA(1, 0), cA + kstep, voffA); PG8_STAGE(PG8_SB(1, 1), cB + hstep + kstep, voffB);
    PG8_WAIT_V(6); PG8_BAR;
    for (;;) {
        const bool has_next = S.next(ui + 1, nxt);
        const char* nA = has_next ? (const char*)g.A + (size_t)nxt.pm * tstep : cA; const char* nB = has_next ? (const char*)g.Bt + (size_t)nxt.pn * tstep : cB;
        for (int t = 0; t < nt; t += 2) {
            const bool last = (t == nt - 2);
            const char* a1 = cA + (size_t)(t + 1) * kstep;
            const char* a2 = last ? nA : cA + (size_t)(t + 2) * kstep; const char* b2 = last ? nB : cB + (size_t)(t + 2) * kstep;
            const char* a3 = a2 + kstep; const char* b3 = b2 + kstep;
            if (last && has_next) S.a_ready(nxt);
            PG8_LDB(B0, 0, 0); PG8_SCHED; PG8_LDA(At, 0, 0); PG8_STAGE(PG8_SA(1, 1), a1 + hstep, voffA);
            PG8_WAIT_L(8); PG8_BAR; PG8_WAIT_L(0); PG8_MMA(0, 0, At, B0); PG8_BAR; PG8_SCHED;
            PG8_LDB(B1, 0, 1); PG8_STAGE(PG8_SB(0, 0), b2, voffB);
            PG8_BAR; PG8_WAIT_L(0); PG8_MMA(0, 1, At, B1); PG8_BAR;
            PG8_LDA(At, 0, 1); PG8_STAGE(PG8_SA(0, 0), a2, voffA);
            PG8_BAR; PG8_WAIT_L(0); PG8_MMA(1, 0, At, B0); PG8_BAR; PG8_SCHED;
            PG8_STAGE(PG8_SB(0, 1), b2 + hstep, voffB);
            PG8_WAIT_V(6); PG8_BAR; PG8_MMA(1, 1, At, B1); PG8_BAR;
            PG8_LDB(B0, 1, 0); PG8_SCHED; PG8_LDA(At, 1, 0); PG8_STAGE(PG8_SA(0, 1), a2 + hstep, voffA);
            PG8_WAIT_L(8); PG8_BAR; PG8_WAIT_L(0); PG8_MMA(0, 0, At, B0); PG8_BAR; PG8_SCHED;
            PG8_LDB(B1, 1, 1); PG8_STAGE(PG8_SB(1, 0), b3, voffB);
            PG8_BAR; PG8_WAIT_L(0); PG8_MMA(0, 1, At, B1); PG8_BAR;
            PG8_LDA(At, 1, 1); PG8_STAGE(PG8_SA(1, 0), a3, voffA);
            PG8_BAR; PG8_WAIT_L(0); PG8_MMA(1, 0, At, B0); PG8_BAR; PG8_SCHED;
            PG8_STAGE(PG8_SB(1, 1), b3 + hstep, voffB);
            PG8_WAIT_V(6); PG8_BAR; PG8_MMA(1, 1, At, B1); PG8_BAR;
        }
        E(acc, cur, wr, wc, fr, fq); S.done(cur);
        if (!has_next) break;
#pragma unroll
        for (int a = 0; a < 2; ++a)
#pragma unroll
            for (int b = 0; b < 2; ++b)
#pragma unroll
                for (int m = 0; m < 4; ++m)
#pragma unroll
                    for (int n = 0; n < 2; ++n) acc[a][b][m][n] = (f32x4){0.f, 0.f, 0.f, 0.f};
        cur = nxt; cA = nA; cB = nB; ++ui;
    }
    PG8_WAIT_V(0);
    if (wr == 0) PG8_BAR;
    PG8_BAR;
#undef PG8_SA
#undef PG8_SB
#undef PG8_STAGE
#undef PG8_LDA
#undef PG8_LDB
#undef PG8_MMA
#undef PG8_WAIT_V
#undef PG8_WAIT_L
#undef PG8_BAR
#undef PG8_SCHED
}
template <class Epi>
__device__ __forceinline__ void run_gemm(int WAVE_S, LAS unsigned char* lds, const bf16_t* A, const bf16_t* Bt, int M, int N, int K, const Epi& E, int vb = -1) {
    Gemm g{A, Bt, M, N, K}; StaticOrder S; S.init(M, N, (int)gridDim.x, vb < 0 ? (int)blockIdx.x : vb);
    gemm_phase<Epi, StaticOrder>(WAVE_S, lds, g, S, E);
    __syncthreads();
}
}

namespace att {
constexpr int D = 128, NW = 8, QBLK = 32, KVBLK = 64;
constexpr float SCALE = 0.088388347648318440f;
constexpr float THR = 8.f;
constexpr int SHM_V = KVBLK * D * 2, SHM_K = KVBLK * D * 2, SHM_ATTN = 2 * SHM_V + 2 * SHM_K + NW * 64 * 4;
#define KSWZ(row, colB) ((row) * 256 + ((colB) ^ (((row) & 7) << 4)))
#define SBAR() __builtin_amdgcn_sched_barrier(0)
__device__ __forceinline__ int crow(int r, int hi) { return (r & 3) + 8 * (r >> 2) + 4 * hi; }
__device__ __forceinline__ unsigned cvtpk(float lo, float hi) { unsigned r; asm volatile("v_cvt_pk_bf16_f32 %0, %1, %2" : "=v"(r) : "v"(lo), "v"(hi)); return r; }
__device__ __forceinline__ void partialSM(f32x16& p0, f32x16& p1, float& m_reg, float& mn, float& alpha, bool masked) {
  constexpr float C = SCALE * 1.4426950408889634f;
  if (masked) {
#pragma unroll
    for (int r = 0; r < 16; ++r) { p0[r] = -1e30f; p1[r] = -1e30f; } }
  float pmax = p0[0];
#pragma unroll
  for (int r = 1; r < 16; ++r) pmax = fmaxf(pmax, p0[r]);
#pragma unroll
  for (int r = 0; r < 16; ++r) pmax = fmaxf(pmax, p1[r]);
  { auto rr = __builtin_amdgcn_permlane32_swap(__float_as_uint(pmax), __float_as_uint(pmax), false, false);
    pmax = fmaxf(__uint_as_float(rr[0]), __uint_as_float(rr[1])); }
  if (__builtin_expect(__all(pmax - m_reg <= THR / SCALE), 1)) { mn = m_reg; alpha = 1.f; }
  else { mn = fmaxf(m_reg, pmax); alpha = __builtin_amdgcn_exp2f((m_reg - mn) * C); m_reg = mn; }
  float mnC = -mn * C;
#pragma unroll
  for (int r = 0; r < 16; ++r) p0[r] = fmaf(p0[r], C, mnC);
#pragma unroll
  for (int r = 0; r < 16; ++r) p1[r] = fmaf(p1[r], C, mnC);
#pragma unroll
  for (int r = 0; r < 16; ++r) p0[r] = __builtin_amdgcn_exp2f(p0[r]);
}
__device__ __forceinline__ void finishSM(f32x16& p0, f32x16& p1, float alpha, float& l_reg, bf16x8& pa0, bf16x8& pa1, bf16x8& pa2, bf16x8& pa3) {
#pragma unroll
  for (int r = 0; r < 16; ++r) p1[r] = __builtin_amdgcn_exp2f(p1[r]);
  float ps = 0;
#pragma unroll
  for (int r = 0; r < 16; ++r) ps += p0[r];
#pragma unroll
  for (int r = 0; r < 16; ++r) ps += p1[r];
  { auto rr = __builtin_amdgcn_permlane32_swap(__float_as_uint(ps), __float_as_uint(ps), false, false);
    ps = __uint_as_float(rr[0]) + __uint_as_float(rr[1]); }
  l_reg = l_reg * alpha + ps;
#define PK4(P, BASE, OUT) do { unsigned a0 = cvtpk(P[BASE + 0], P[BASE + 1]), a1 = cvtpk(P[BASE + 2], P[BASE + 3]);   \
    unsigned b0 = cvtpk(P[BASE + 4], P[BASE + 5]), b1 = cvtpk(P[BASE + 6], P[BASE + 7]);                              \
    auto r0 = __builtin_amdgcn_permlane32_swap(a0, b0, false, false); auto r1 = __builtin_amdgcn_permlane32_swap(a1, b1, false, false); \
    u32x4 w = {r0[0], r1[0], r0[1], r1[1]}; OUT = *reinterpret_cast<bf16x8*>(&w); } while (0)
  PK4(p0, 0, pa0); PK4(p0, 8, pa1); PK4(p1, 0, pa2); PK4(p1, 8, pa3);
#undef PK4
}
__device__ __forceinline__ void qkt(f32x16& p0, f32x16& p1, const bf16_t* Ks, const bf16x8* qr, int r32, int hi) {
  p0 = f32x16{}; p1 = f32x16{};
#pragma unroll
  for (int d0 = 0; d0 < 8; ++d0) { int cb = (d0 * 16 + hi * 8) * 2;
    bf16x8 b0 = *reinterpret_cast<const bf16x8*>((const char*)Ks + KSWZ(r32, cb));
    bf16x8 b1 = *reinterpret_cast<const bf16x8*>((const char*)Ks + KSWZ(32 + r32, cb));
    p0 = __builtin_amdgcn_mfma_f32_32x32x16_bf16(b0, qr[d0], p0, 0, 0, 0);
    p1 = __builtin_amdgcn_mfma_f32_32x32x16_bf16(b1, qr[d0], p1, 0, 0, 0); }
}
__device__ __forceinline__ int v_st(int k, int c) { const int kk = (k & ~0xC) | ((k & 4) << 1) | ((k & 8) >> 1); return ((kk >> 3) * 4 + (c >> 5)) * 512 + ((kk & 7) * 32 + (c & 31)) * 2; }
__device__ __forceinline__ int v_rd_base(int lane) { return ((lane & 3) << 3) | (((lane >> 2) & 3) << 6) | (((lane >> 4) & 1) << 5) | (((lane >> 5) & 1) << 8); }
constexpr int v_rd_off(int d0, int ks, int half) { return d0 * 512 + ks * 4096 + half * 2048; }
template <int OFF> __device__ __forceinline__ s16x4 tr_read(int vb) {
  s16x4 r; asm volatile("ds_read_b64_tr_b16 %0, %1 offset:%2" : "=&v"(r) : "v"(vb), "i"(OFF) : "memory"); return r;
}
template <int D0> __device__ __forceinline__ void pv_one(f32x16& od, int vb, bf16x8 pa0, bf16x8 pa1, bf16x8 pa2, bf16x8 pa3) {
  const s16x4 l0 = tr_read<v_rd_off(D0, 0, 0)>(vb), h0 = tr_read<v_rd_off(D0, 0, 1)>(vb), l1 = tr_read<v_rd_off(D0, 1, 0)>(vb), h1 = tr_read<v_rd_off(D0, 1, 1)>(vb);
  const s16x4 l2 = tr_read<v_rd_off(D0, 2, 0)>(vb), h2 = tr_read<v_rd_off(D0, 2, 1)>(vb), l3 = tr_read<v_rd_off(D0, 3, 0)>(vb), h3 = tr_read<v_rd_off(D0, 3, 1)>(vb);
  asm volatile("s_waitcnt lgkmcnt(0)" ::: "memory"); SBAR();
#define PK(L, H) (bf16x8){L[0], L[1], L[2], L[3], H[0], H[1], H[2], H[3]}
  od = __builtin_amdgcn_mfma_f32_32x32x16_bf16(pa0, PK(l0, h0), od, 0, 0, 0);
  od = __builtin_amdgcn_mfma_f32_32x32x16_bf16(pa1, PK(l1, h1), od, 0, 0, 0);
  od = __builtin_amdgcn_mfma_f32_32x32x16_bf16(pa2, PK(l2, h2), od, 0, 0, 0);
  od = __builtin_amdgcn_mfma_f32_32x32x16_bf16(pa3, PK(l3, h3), od, 0, 0, 0);
#undef PK
}
__device__ __forceinline__ void pv_d0(f32x16* o, int vb, bf16x8 pa0, bf16x8 pa1, bf16x8 pa2, bf16x8 pa3) {
  pv_one<0>(o[0], vb, pa0, pa1, pa2, pa3); pv_one<1>(o[1], vb, pa0, pa1, pa2, pa3); pv_one<2>(o[2], vb, pa0, pa1, pa2, pa3); pv_one<3>(o[3], vb, pa0, pa1, pa2, pa3);
}
constexpr int LDR = 6144, LDO = 2048;
__device__ __forceinline__ void attn_body(int WAVE_S, const bf16_t* __restrict__ Qb, const bf16_t* __restrict__ Kh, const bf16_t* __restrict__ Vh,
                                          bf16_t* __restrict__ Ob, int seq, char* lds) {
  const int tid = opaque_tid(), wid = tid >> 6, lane = tid & 63, r32 = lane & 31, hi = lane >> 5;
  bf16_t* V_lds = (bf16_t*)lds; bf16_t* K_lds = (bf16_t*)(lds + 2 * SHM_V);
  float* ws = (float*)(lds + 2 * SHM_V + 2 * SHM_K) + wid * 64; float* li_l = ws; float* al_l = ws + 32;
  float m_reg = -1e30f, l_reg = 0; f32x16 o[4] = {}; bf16x8 qr[8];
  const bf16_t* Qw = Qb + (long)(wid * QBLK + r32) * LDR + hi * 8;
#pragma unroll
  for (int d0 = 0; d0 < 8; ++d0) qr[d0] = *reinterpret_cast<const bf16x8*>(Qw + d0 * 16);
  const int sr = tid >> 4, sc = (tid & 15) * 8, vst0 = v_st(sr, sc), vst1 = v_st(32 + sr, sc);
  const int vb0 = (int)(uintptr_t)V_lds + v_rd_base(lane);
  struct { bf16x8 vs0, vs1, ks0, ks1; } sr_[2];
#define SLOAD(i, k0) do { sr_[i].vs0 = *reinterpret_cast<const bf16x8*>(&Vh[(long)((k0) + sr) * LDR + sc]); sr_[i].vs1 = *reinterpret_cast<const bf16x8*>(&Vh[(long)((k0) + 32 + sr) * LDR + sc]); \
    sr_[i].ks0 = *reinterpret_cast<const bf16x8*>(&Kh[(long)((k0) + sr) * LDR + sc]); sr_[i].ks1 = *reinterpret_cast<const bf16x8*>(&Kh[(long)((k0) + 32 + sr) * LDR + sc]); } while (0)
#define SWRITE(b, i) do { *(bf16x8*)((char*)V_lds + (b) * SHM_V + vst0) = sr_[i].vs0;          \
    *(bf16x8*)((char*)V_lds + (b) * SHM_V + vst1) = sr_[i].vs1; int kc = sc * 2;               \
    *(bf16x8*)((char*)K_lds + (b) * SHM_K + KSWZ(sr, kc)) = sr_[i].ks0;                       \
    *(bf16x8*)((char*)K_lds + (b) * SHM_K + KSWZ(32 + sr, kc)) = sr_[i].ks1; } while (0)
#define SWAIT() asm volatile("s_waitcnt vmcnt(4)" ::: "memory")
#define RESC(a) do { if (__any((a) < 1.f)) { if (hi == 0) al_l[r32] = (a); asm volatile("s_waitcnt lgkmcnt(0)" ::: "memory"); \
    for (int d = 0; d < 4; ++d) for (int r = 0; r < 16; ++r) o[d][r] *= al_l[crow(r, hi)]; } } while (0)
  f32x16 pA0, pA1, pB0, pB1; float mnA, mnB, alA, alB; bf16x8 pa0, pa1, pa2, pa3; const int NT = seq / KVBLK;
  const int last_vis = NT - 4 + (wid >> 1);
  constexpr int SE = 0, SO = 1;
  SLOAD(SE, 0); asm volatile("s_waitcnt vmcnt(0)" ::: "memory"); SWRITE(0, SE); __syncthreads();
  qkt(pA0, pA1, K_lds, qr, r32, hi); partialSM(pA0, pA1, m_reg, mnA, alA, false);
  SLOAD(SO, KVBLK); if (2 < NT) SLOAD(SE, 2 * KVBLK);
  SWAIT(); SWRITE(1, SO); __syncthreads();
  for (int j = 1; j + 1 < NT; j += 2) {
    SBAR(); qkt(pB0, pB1, (bf16_t*)((char*)K_lds + SHM_K), qr, r32, hi);
    finishSM(pA0, pA1, alA, l_reg, pa0, pa1, pa2, pa3); SBAR();
    SLOAD(SO, (j + 2) * KVBLK); SBAR();
    pv_d0(o, vb0, pa0, pa1, pa2, pa3); partialSM(pB0, pB1, m_reg, mnB, alB, j > last_vis);
    __syncthreads(); SWAIT(); SWRITE(0, SE);
    RESC(alB); __syncthreads();
    SBAR(); qkt(pA0, pA1, K_lds, qr, r32, hi);
    finishSM(pB0, pB1, alB, l_reg, pa0, pa1, pa2, pa3); SBAR();
    if (j + 3 < NT) SLOAD(SE, (j + 3) * KVBLK); SBAR();
    pv_d0(o, vb0 + (int)SHM_V, pa0, pa1, pa2, pa3); partialSM(pA0, pA1, m_reg, mnA, alA, (j + 1) > last_vis);
    __syncthreads(); SWAIT(); SWRITE(1, SO);
    RESC(alA); __syncthreads();
  }
  SBAR(); qkt(pB0, pB1, (bf16_t*)((char*)K_lds + SHM_K), qr, r32, hi);
  finishSM(pA0, pA1, alA, l_reg, pa0, pa1, pa2, pa3); SBAR();
  pv_d0(o, vb0, pa0, pa1, pa2, pa3); partialSM(pB0, pB1, m_reg, mnB, alB, (NT - 1) > last_vis);
  __syncthreads(); RESC(alB);
  finishSM(pB0, pB1, alB, l_reg, pa0, pa1, pa2, pa3); SBAR();
  pv_d0(o, vb0 + (int)SHM_V, pa0, pa1, pa2, pa3);
  if (hi == 0) li_l[r32] = l_reg; asm volatile("s_waitcnt lgkmcnt(0)" ::: "memory");
  float rli[16];
#pragma unroll
  for (int r = 0; r < 16; ++r) rli[r] = __builtin_amdgcn_rcpf(li_l[crow(r, hi)]);
  bf16_t* Ow = Ob + (long)(wid * QBLK) * LDO;
#pragma unroll
  for (int r = 0; r < 16; ++r) { int orow = crow(r, hi);
#pragma unroll
    for (int d0 = 0; d0 < 4; ++d0) Ow[(long)orow * LDO + d0 * 32 + r32] = f2bf(o[d0][r] * rli[r]); }
#undef SLOAD
#undef SWRITE
#undef SWAIT
#undef RESC
}
}

struct Params { const void* in[29]; float* out; unsigned char* ws; int ph_lo, ph_hi; };

__device__ void cvt_weight(int WAVE_S, LAS unsigned char* L, const float* __restrict__ src, bf16_t* __restrict__ dst, int K, int N, const float* __restrict__ gain = nullptr, int vb = -1, int vg = 0) {
    LAS float* tile = (LAS float*)L;
    const int tid = opaque_tid();
    const int ntn = N / 64, ntiles = (K / 64) * ntn;
    const int lr = tid >> 3, lc = (tid & 7) * 8;
    f32x4 v0 = {0.f, 0.f, 0.f, 0.f}, v1 = {0.f, 0.f, 0.f, 0.f};
    if (vb < 0) { vb = blockIdx.x; vg = gridDim.x; }
    int t = vb;
    if (t < ntiles) { const int tk = t / ntn, tn = t % ntn; const float* s = src + (size_t)(tk * 64 + lr) * N + tn * 64 + lc; v0 = *(const f32x4*)s; v1 = *(const f32x4*)(s + 4); }
    for (; t < ntiles; t += vg) {
        const int tk = t / ntn, tn = t % ntn;
        const float gk = gain ? gain[tk * 64 + lr] : 1.f;
        __syncthreads();
#pragma unroll
        for (int j = 0; j < 4; ++j) { tile[lr * 65 + lc + j] = v0[j] * gk; tile[lr * 65 + lc + 4 + j] = v1[j] * gk; }
        __syncthreads();
        const int t2 = t + vg;
        if (t2 < ntiles) { const int tk2 = t2 / ntn, tn2 = t2 % ntn; const float* s = src + (size_t)(tk2 * 64 + lr) * N + tn2 * 64 + lc; v0 = *(const f32x4*)s; v1 = *(const f32x4*)(s + 4); }
        const int n = tid >> 3, kc = (tid & 7) * 8;
        float f[8];
#pragma unroll
        for (int i = 0; i < 8; ++i) f[i] = tile[(kc + i) * 65 + n];
        *(u32x4*)(dst + (size_t)(tn * 64 + n) * K + tk * 64 + kc) = pack8(f);
    }
    __syncthreads();
}

__device__ void rmsnorm_rows(int WAVE_S, const float* __restrict__ X, const float* __restrict__ gain, bf16_t* __restrict__ out, float* __restrict__ copy, int rows) {
    const int tid_ = opaque_tid(); const int lane = tid_ & 63, wave = tid_ >> 6;
#pragma unroll 1
    for (int r = blockIdx.x * 8 + wave; r < rows; r += gridDim.x * 8) {
        const float* x = X + (size_t)r * 2048;
        f32x4 v[8]; float ss = 0.f;
#pragma unroll
        for (int j = 0; j < 8; ++j) { v[j] = *(const f32x4*)(x + j * 256 + lane * 4); ss += v[j][0] * v[j][0] + v[j][1] * v[j][1] + v[j][2] * v[j][2] + v[j][3] * v[j][3]; }
        ss = wave_sum(ss);
        const float rs = rsqrtf(ss * (1.f / 2048.f) + EPS);
#pragma unroll
        for (int j = 0; j < 8; ++j) { const f32x4 g = *(const f32x4*)(gain + j * 256 + lane * 4);
            u32x2 w; w.x = cvt_pk_bf16(v[j][0] * rs * g[0], v[j][1] * rs * g[1]); w.y = cvt_pk_bf16(v[j][2] * rs * g[2], v[j][3] * rs * g[3]);
            *(u32x2*)(out + (size_t)r * 2048 + j * 256 + lane * 4) = w;
            if (copy) *(f32x4*)(copy + (size_t)r * 2048 + j * 256 + lane * 4) = v[j]; }
    }
}

__device__ __forceinline__ void transpose_store(int WAVE_S, LAS bf16_t* tile, bf16_t* __restrict__ dst, size_t ld) {
#pragma unroll 2
    for (int idx = opaque_tid(); idx < 256 * 8; idx += NTHR) { const int d = idx >> 3, sc = idx & 7;
        unsigned short e[8];
#pragma unroll
        for (int i = 0; i < 8; ++i) e[i] = tile[(sc * 8 + i) * 264 + d];
        u32x4 w; w.x = e[0] | ((unsigned)e[1] << 16); w.y = e[2] | ((unsigned)e[3] << 16); w.z = e[4] | ((unsigned)e[5] << 16); w.w = e[6] | ((unsigned)e[7] << 16);
        *(u32x4*)(dst + (size_t)d * ld + sc * 8) = w; }
}
__device__ __forceinline__ void tile_load(int WAVE_S, LAS bf16_t* tile, const bf16_t* __restrict__ src, size_t ld) {
#pragma unroll
    for (int idx = opaque_tid(); idx < 64 * 32; idx += NTHR) { const int r = idx >> 5, c = (idx & 31) * 8;
        *(LAS u32x4*)(tile + r * 264 + c) = *(const u32x4*)(src + (size_t)r * ld + c); }
}

__device__ void l0_prep_item(int WAVE_S, LAS unsigned char* L, bf16_t* A1, const int* __restrict__ pos, bf16_t* KT, bf16_t* VT, int item) {
    const int h = item & 3, c = (item >> 2) & 63, b = item >> 8;
    const int tid = opaque_tid();
    const size_t tok0 = (size_t)b * SEQ + c * 64;
    LAS bf16_t* tile = (LAS bf16_t*)L;
    __syncthreads();
#pragma unroll 2
    for (int pass = 0; pass < 2; ++pass) {
        const int s = (tid >> 4) + pass * 32, i0 = (tid & 15) * 8;
        const float p = (float)pos[tok0 + s];
        float cs[8], sn[8];
#pragma unroll
        for (int i = 0; i < 8; ++i) { const float inv = exp2f(-(float)(i0 + i) * (LOG2_THETA / 128.f)); fast_sincos(p * inv, &sn[i], &cs[i]); }
        bf16_t* row = A1 + (tok0 + s) * 8192;
        {   bf16_t* q = row + h * 256; float x1[8], x2[8], y1[8], y2[8];
            unpack8(*(const u32x4*)(q + i0), x1); unpack8(*(const u32x4*)(q + 128 + i0), x2);
#pragma unroll
            for (int i = 0; i < 8; ++i) { y1[i] = x1[i] * cs[i] - x2[i] * sn[i]; y2[i] = x2[i] * cs[i] + x1[i] * sn[i]; }
            *(u32x4*)(q + i0) = pack8(y1); *(u32x4*)(q + 128 + i0) = pack8(y2); }
        {   bf16_t* k = row + 1024 + h * 256; float x1[8], x2[8], y1[8], y2[8];
            unpack8(*(const u32x4*)(k + i0), x1); unpack8(*(const u32x4*)(k + 128 + i0), x2);
#pragma unroll
            for (int i = 0; i < 8; ++i) { y1[i] = (x1[i] * cs[i] - x2[i] * sn[i]) * 0.0625f; y2[i] = (x2[i] * cs[i] + x1[i] * sn[i]) * 0.0625f; }
            const u32x4 w1 = pack8(y1), w2 = pack8(y2);
            *(u32x4*)(k + i0) = w1; *(u32x4*)(k + 128 + i0) = w2;
            if (RET_NAIVE == 2) { *(LAS u32x4*)(tile + s * 264 + i0) = w1; *(LAS u32x4*)(tile + s * 264 + 128 + i0) = w2; } }
    }
    __syncthreads();
    if (RET_NAIVE == 2) transpose_store(WAVE_S, tile, KT + ((size_t)(b * 4 + h) * 256) * SEQ + c * 64, SEQ);
    for (int half = 0; half < 2; ++half) {
        __syncthreads();
        tile_load(WAVE_S, tile, A1 + tok0 * 8192 + 2048 + h * 512 + half * 256, 8192);
        __syncthreads();
        transpose_store(WAVE_S, tile, VT + ((size_t)(b * 4 + h) * 512 + half * 256) * SEQ + c * 64, SEQ);
    }
}

__device__ void xa_prep_item(int WAVE_S, LAS unsigned char* L, bf16_t* KVX, bf16_t* XVT, const float* __restrict__ kg, const float* __restrict__ qg, int item) {
    const int kc = item & 3, h = (item >> 2) & 3, b = item >> 4;
    const int tid = opaque_tid(), lane = tid & 63, wave = tid >> 6;
    LAS bf16_t* tile = (LAS bf16_t*)L;
    const size_t row0 = (size_t)b * 256 + kc * 64;
    float g[8];
#pragma unroll
    for (int i = 0; i < 8; ++i) g[i] = kg[lane * 8 + i] * qg[lane * 8 + i];
#pragma unroll 4
    for (int r = wave; r < 64; r += 8) {
        bf16_t* k = KVX + (row0 + r) * 4096 + h * 512 + lane * 8; float x[8];
        unpack8(*(const u32x4*)k, x); float ss = 0.f;
#pragma unroll
        for (int i = 0; i < 8; ++i) ss += x[i] * x[i];
        ss = wave_sum(ss); const float rs = rsqrtf(ss * (1.f / 512.f) + EPS);
#pragma unroll
        for (int i = 0; i < 8; ++i) x[i] = x[i] * rs * g[i];
        *(u32x4*)k = pack8(x);
    }
    for (int half = 0; half < 2; ++half) {
        __syncthreads();
        tile_load(WAVE_S, tile, KVX + row0 * 4096 + 2048 + h * 512 + half * 256, 4096);
        __syncthreads();
        transpose_store(WAVE_S, tile, XVT + ((size_t)(b * 4 + h) * 512 + half * 256) * 256 + kc * 64, 256);
    }
    __syncthreads();
}

__device__ void retention_item(int WAVE_S, LAS unsigned char* L, const bf16_t* __restrict__ A1, const bf16_t* __restrict__ KT, const bf16_t* __restrict__ VT,
                               bf16_t* __restrict__ A2, float* __restrict__ ssq, int bh, int slice) {
    constexpr int QS = 0, KS = 33792, KTS = 67584, VTS = 104448, VDS = 109056, SSO = 113664, STS = 122880;
    const int b = bh >> 2, h = bh & 3;
    const int tid = opaque_tid(), lane = tid & 63, w = tid >> 6, l15 = lane & 15, quad = lane >> 4;
    const float gamma = 1.f - exp2f(-5.f - (float)h);
    const float lg = log2f(gamma);
    __syncthreads();
    for (int i = tid; i < 16896 / 4; i += NTHR) ((LAS unsigned*)(L + STS))[i] = 0u;
    f32x4 st[2][2];
#pragma unroll
    for (int a = 0; a < 2; ++a)
#pragma unroll
        for (int e = 0; e < 2; ++e) st[a][e] = (f32x4){0.f, 0.f, 0.f, 0.f};
    const bf16_t* qb = A1 + (size_t)b * SEQ * 8192 + h * 256;
    const bf16_t* kb = qb + 1024;
    const bf16_t* ktb = KT + (size_t)bh * 256 * SEQ;
    const bf16_t* vtb = VT + ((size_t)bh * 512 + slice * 32) * SEQ;
    u32x4 rq[4], rk[4], rkt[4], rvt = {0u, 0u, 0u, 0u};
    float vdec[8];
#pragma unroll
    for (int i = 0; i < 8; ++i) vdec[i] = exp2f(lg * (float)(64 - ((tid & 7) * 8 + i)));
#define RET_GLOAD(c) do { _Pragma("unroll") for (int i = 0; i < 4; ++i) { const int p = tid + NTHR * i; const int r = p >> 5, cc = (p & 31) * 8; \
            rq[i] = *(const u32x4*)(qb + (size_t)((c) * 64 + r) * 8192 + cc); rk[i] = *(const u32x4*)(kb + (size_t)((c) * 64 + r) * 8192 + cc); \
            const int d = p >> 3, c2 = (p & 7) * 8; rkt[i] = *(const u32x4*)(ktb + (size_t)d * SEQ + (c) * 64 + c2); } \
        if (tid < 256) rvt = *(const u32x4*)(vtb + (size_t)(tid >> 3) * SEQ + (c) * 64 + (tid & 7) * 8); } while (0)
    RET_GLOAD(0);
    const int it = w >> 1, jt0 = (w & 1) * 2, et = w & 1;
    const float cd = exp2f(lg * 64.f);
    for (int c = 0; c < 64; ++c) {
        __syncthreads();
#pragma unroll
        for (int i = 0; i < 4; ++i) { const int p = tid + NTHR * i; const int r = p >> 5, cc = (p & 31) * 16;
            *(LAS u32x4*)(L + QS + r * 528 + cc) = rq[i]; *(LAS u32x4*)(L + KS + r * 528 + cc) = rk[i];
            const int d = p >> 3, c2 = (p & 7) * 16; *(LAS u32x4*)(L + KTS + d * 144 + c2) = rkt[i]; }
        if (tid < 256) { const int e = tid >> 3, c2 = (tid & 7) * 16; *(LAS u32x4*)(L + VTS + e * 144 + c2) = rvt;
            float f[8]; unpack8(rvt, f);
#pragma unroll
            for (int i = 0; i < 8; ++i) f[i] *= vdec[i];
            *(LAS u32x4*)(L + VDS + e * 144 + c2) = pack8(f); }
        __syncthreads();
        if (c + 1 < 64) RET_GLOAD(c + 1);
        f32x4 s0 = {0.f, 0.f, 0.f, 0.f}, s1 = s0, qs = s0;
#pragma unroll 2
        for (int ks = 0; ks < 8; ++ks) { const int kb_ = ks * 64 + quad * 16;
            const bf16x8 a = ldfrag(L + QS, it * 16 + l15, 528, kb_);
            const bf16x8 b0 = ldfrag(L + KS, jt0 * 16 + l15, 528, kb_);
            const bf16x8 b1 = ldfrag(L + KS, (jt0 + 1) * 16 + l15, 528, kb_);
            const bf16x8 bs = ldfrag(L + STS, et * 16 + l15, 528, kb_);
            s0 = mfma16(a, b0, s0); s1 = mfma16(a, b1, s1); qs = mfma16(a, bs, qs); }
#pragma unroll
        for (int r = 0; r < 4; ++r) { const int i = it * 16 + quad * 4 + r; const int j0 = jt0 * 16 + l15, j1 = j0 + 16;
            ((LAS bf16_t*)(L + SSO + i * 144))[j0] = f2bf(s0[r] * exp2f(lg * fabsf((float)(i - j0))));
            ((LAS bf16_t*)(L + SSO + i * 144))[j1] = f2bf(s1[r] * exp2f(lg * fabsf((float)(i - j1)))); }
        __syncthreads();
        f32x4 sv = {0.f, 0.f, 0.f, 0.f};
#pragma unroll
        for (int ks = 0; ks < 2; ++ks) { const int kb_ = ks * 64 + quad * 16;
            sv = mfma16(ldfrag(L + SSO, it * 16 + l15, 144, kb_), ldfrag(L + VTS, et * 16 + l15, 144, kb_), sv); }
        {
#pragma unroll
            for (int r = 0; r < 4; ++r) { const int i = it * 16 + quad * 4 + r;
                const float o = (RETPART == 1) ? sv[r] : (RETPART == 2) ? exp2f(lg * (float)i) * qs[r] : sv[r] + exp2f(lg * (float)i) * qs[r];
                A2[((size_t)(bh * 16 + slice) * SEQ + c * 64 + i) * 32 + et * 16 + l15] = f2bf(o); } }
#pragma unroll
        for (int dt = 0; dt < 2; ++dt)
#pragma unroll
            for (int e2 = 0; e2 < 2; ++e2) { f32x4 a = st[dt][e2] * cd;
#pragma unroll
                for (int ks = 0; ks < 2; ++ks) { const int kb_ = ks * 64 + quad * 16;
                    a = mfma16(ldfrag(L + KTS, (2 * w + dt) * 16 + l15, 144, kb_), ldfrag(L + VDS, e2 * 16 + l15, 144, kb_), a); }
                st[dt][e2] = a;
                u32x2 pk; pk.x = cvt_pk_bf16(a[0], a[1]); pk.y = cvt_pk_bf16(a[2], a[3]);
                *(LAS u32x2*)(L + STS + (e2 * 16 + l15) * 528 + ((2 * w + dt) * 16 + quad * 4) * 2) = pk; }
    }
#undef RET_GLOAD
    __syncthreads();
}


__device__ void retention_quad_item(int WAVE_S, LAS unsigned char* L, const bf16_t* __restrict__ A1, const bf16_t* __restrict__ VT, bf16_t* __restrict__ A2, const float* __restrict__ rg, int bh, int c) {
    constexpr int QS = 0, KS = 33792, VTC = 67584, SSO = 141312, RSO = 150528;
    const int b = bh >> 2, h = bh & 3;
    const int tid = opaque_tid(), lane = tid & 63, w = tid >> 6, l15 = lane & 15, quad = lane >> 4;
    const float lg = log2f(1.f - exp2f(-5.f - (float)h));
    const bf16_t* qb = A1 + ((size_t)b * SEQ + c * 64) * 8192 + h * 256;
    const bf16_t* kb0 = A1 + (size_t)b * SEQ * 8192 + 1024 + h * 256;
    const bf16_t* vtb = VT + (size_t)bh * 512 * SEQ;
    const int it = w >> 1, jt0 = (w & 1) * 2;
    const int et0 = w * 4;
    f32x4 acc[4][4];
#pragma unroll
    for (int a = 0; a < 4; ++a)
#pragma unroll
        for (int t = 0; t < 4; ++t) acc[a][t] = (f32x4){0.f, 0.f, 0.f, 0.f};
    u32x4 rk[4], rv[8];
#define RQ_GLOAD(cp_) do { _Pragma("unroll") for (int i = 0; i < 4; ++i) { const int p = tid + NTHR * i; rk[i] = *(const u32x4*)(kb0 + (size_t)((cp_) * 64 + (p >> 5)) * 8192 + (p & 31) * 8); } \
        _Pragma("unroll") for (int i = 0; i < 8; ++i) { const int p = tid + NTHR * i; rv[i] = *(const u32x4*)(vtb + (size_t)(p >> 3) * SEQ + (cp_) * 64 + (p & 7) * 8); } } while (0)
    RQ_GLOAD(0);
    {   u32x4 rq[4];
#pragma unroll
        for (int i = 0; i < 4; ++i) { const int p = tid + NTHR * i; rq[i] = *(const u32x4*)(qb + (size_t)(p >> 5) * 8192 + (p & 31) * 8); }
        __syncthreads();
#pragma unroll
        for (int i = 0; i < 4; ++i) { const int p = tid + NTHR * i; *(LAS u32x4*)(L + QS + (p >> 5) * 528 + (p & 31) * 16) = rq[i]; } }
#pragma unroll 1
    for (int cp = 0; cp <= c; ++cp) {
        __syncthreads();
#pragma unroll
        for (int i = 0; i < 4; ++i) { const int p = tid + NTHR * i; *(LAS u32x4*)(L + KS + (p >> 5) * 528 + (p & 31) * 16) = rk[i]; }
#pragma unroll
        for (int i = 0; i < 8; ++i) { const int p = tid + NTHR * i; *(LAS u32x4*)(L + VTC + (p >> 3) * 144 + (p & 7) * 16) = rv[i]; }
        __syncthreads();
        if (cp < c) RQ_GLOAD(cp + 1);
        f32x4 s0 = {0.f, 0.f, 0.f, 0.f}, s1 = s0;
#pragma unroll
        for (int ks = 0; ks < 8; ++ks) { const int kb_ = ks * 64 + quad * 16;
            const bf16x8 a = ldfrag(L + QS, it * 16 + l15, 528, kb_);
            s0 = mfma16(a, ldfrag(L + KS, jt0 * 16 + l15, 528, kb_), s0);
            s1 = mfma16(a, ldfrag(L + KS, (jt0 + 1) * 16 + l15, 528, kb_), s1); }
        const float base = (float)(64 * (c - cp));
#pragma unroll
        for (int r = 0; r < 4; ++r) { const int i = it * 16 + quad * 4 + r; const int j0 = jt0 * 16 + l15, j1 = j0 + 16;
            const float w0 = (cp == c) ? exp2f(lg * fabsf((float)(i - j0))) : exp2f(lg * (base + (float)(i - j0)));
            const float w1 = (cp == c) ? exp2f(lg * fabsf((float)(i - j1))) : exp2f(lg * (base + (float)(i - j1)));
            ((LAS bf16_t*)(L + SSO + i * 144))[j0] = f2bf(s0[r] * w0);
            ((LAS bf16_t*)(L + SSO + i * 144))[j1] = f2bf(s1[r] * w1); }
        __syncthreads();
#pragma unroll
        for (int ks = 0; ks < 2; ++ks) { const int kb_ = ks * 64 + quad * 16;
            bf16x8 sa[4], vb[4];
#pragma unroll
            for (int a = 0; a < 4; ++a) sa[a] = ldfrag(L + SSO, a * 16 + l15, 144, kb_);
#pragma unroll
            for (int t = 0; t < 4; ++t) vb[t] = ldfrag(L + VTC, (et0 + t) * 16 + l15, 144, kb_);
#pragma unroll
            for (int a = 0; a < 4; ++a)
#pragma unroll
                for (int t = 0; t < 4; ++t) acc[a][t] = mfma16(sa[a], vb[t], acc[a][t]); }
    }
#undef RQ_GLOAD
    LAS float* rsum = (LAS float*)(L + RSO);
#pragma unroll
    for (int a = 0; a < 4; ++a)
#pragma unroll
        for (int r = 0; r < 4; ++r) { float ss = 0.f;
#pragma unroll
            for (int t = 0; t < 4; ++t) ss += acc[a][t][r] * acc[a][t][r];
            ss += __shfl_xor(ss, 1); ss += __shfl_xor(ss, 2); ss += __shfl_xor(ss, 4); ss += __shfl_xor(ss, 8);
            if (l15 == 0) rsum[(a * 16 + quad * 4 + r) * 8 + w] = ss; }
    __syncthreads();
    const size_t tok0 = (size_t)b * SEQ + c * 64;
#pragma unroll
    for (int a = 0; a < 4; ++a)
#pragma unroll
        for (int r = 0; r < 4; ++r) { const int i = a * 16 + quad * 4 + r;
            const f32x4 p0 = *(LAS f32x4*)(rsum + i * 8), p1 = *(LAS f32x4*)(rsum + i * 8 + 4);
            const float rs = rsqrtf(((p0[0] + p0[1]) + (p0[2] + p0[3]) + (p1[0] + p1[1]) + (p1[2] + p1[3])) * (1.f / 512.f) + EPS);
#pragma unroll
            for (int t = 0; t < 4; ++t) { const int e = (et0 + t) * 16 + l15;
                const float g = bf2f(A1[(tok0 + i) * 8192 + 4096 + h * 512 + e]);
                const float sl = g / (1.f + __expf(-g));
                A2[(tok0 + i) * 3072 + h * 512 + e] = f2bf(sl * acc[a][t][r] * rs * rg[h * 512 + e]); } }
}

__device__ void retention_naive(int WAVE_S, LAS unsigned char* L, const bf16_t* __restrict__ A1, bf16_t* __restrict__ RETB, const bf16_t* __restrict__ KT, const bf16_t* __restrict__ VT) {
    LAS float* pw = (LAS float*)L;
    LAS float* qv = (LAS float*)(L + 16384);
    const int tid = opaque_tid();
#pragma unroll 1
    for (int item = blockIdx.x; item < T_TOK * 4; item += gridDim.x) {
        const int h = item & 3, tok = item >> 2, b = tok >> 12, n = tok & 4095, cn = n >> 6, nk = (cn + 1) * 64;
        const float lg = log2f(1.f - exp2f(-5.f - (float)h));
        __syncthreads();
        if (tid < 256) qv[tid] = bf2f(A1[(size_t)tok * 8192 + h * 256 + tid]);
        __syncthreads();
        for (int m = tid; m < nk; m += NTHR) {
            const bf16_t* kr = A1 + ((size_t)b * SEQ + m) * 8192 + 1024 + h * 256; float d = 0.f;
            if (NAIVE_SRC) { for (int k = 0; k < 256; ++k) d += bf2f(KT[((size_t)(b * 4 + h) * 256 + k) * SEQ + m]) * qv[k]; }
            else for (int k = 0; k < 256; k += 8) { float f[8]; unpack8(*(const u32x4*)(kr + k), f);
#pragma unroll
                for (int i = 0; i < 8; ++i) d += f[i] * qv[k + i]; }
            pw[m] = d * (((m >> 6) == cn) ? exp2f(lg * fabsf((float)(n - m))) : exp2f(lg * (float)(n - m)));
        }
        __syncthreads();
        float o = 0.f;
        const bf16_t* vc = A1 + (size_t)b * SEQ * 8192 + 2048 + h * 512 + tid;
        if (NAIVE_SRC) { const bf16_t* vt = VT + ((size_t)(b * 4 + h) * 512 + tid) * SEQ; for (int m = 0; m < nk; ++m) o += pw[m] * bf2f(vt[m]); }
        else for (int m = 0; m < nk; ++m) o += pw[m] * bf2f(vc[(size_t)m * 8192]);
        RETB[((size_t)((b * 4 + h) * 16 + (tid >> 5)) * SEQ + n) * 32 + (tid & 31)] = f2bf(o);
    }
}

__device__ void sg_item(int WAVE_S, LAS unsigned char* L, const bf16_t* __restrict__ A1, bf16_t* __restrict__ A2, const float* __restrict__ sgn, const float* __restrict__ sgw,
                        const float* __restrict__ sgb, int item) {
    const int g = item & 3, nb = (item >> 2) & 31, b = item >> 7;
    const int tid = opaque_tid(), lane = tid & 63, w = tid >> 6, l15 = lane & 15, quad = lane >> 4;
    const size_t tok0 = (size_t)b * SEQ + nb * 128;
    __syncthreads();
    {   const int c0 = (tid & 31) * 8; float gn[8];
#pragma unroll
        for (int i = 0; i < 8; ++i) gn[i] = sgn[g * 256 + c0 + i];
#pragma unroll 4
        for (int pass = 0; pass < 8; ++pass) { const int j = pass * 16 + (tid >> 5);
            float x[8]; unpack8(*(const u32x4*)(A1 + (tok0 + j) * 8192 + 7168 + g * 256 + c0), x);
            float ss = 0.f;
#pragma unroll
            for (int i = 0; i < 8; ++i) { x[i] = gelu_tanh(x[i]); ss += x[i] * x[i]; }
            ss += __shfl_xor(ss, 16); ss += __shfl_xor(ss, 8); ss += __shfl_xor(ss, 4); ss += __shfl_xor(ss, 2); ss += __shfl_xor(ss, 1);
            const float rs = rsqrtf(ss * (1.f / 256.f) + EPS);
#pragma unroll
            for (int i = 0; i < 8; ++i) ((LAS bf16_t*)(L + (c0 + i) * 272))[j] = f2bf(x[i] * rs * gn[i]); }
    }
    bf16x8 bw[4];
    {   const int i = w * 16 + l15; const float* wr = sgw + ((size_t)g * 128 + i) * 128;
#pragma unroll
        for (int ks = 0; ks < 4; ++ks) { const int j0 = ks * 32 + quad * 8; float f[8];
            const f32x4 a = *(const f32x4*)(wr + j0), c = *(const f32x4*)(wr + j0 + 4);
            const bool z = (i < 64) && (j0 >= 64);
#pragma unroll
            for (int q = 0; q < 4; ++q) { f[q] = z ? 0.f : a[q]; f[4 + q] = z ? 0.f : c[q]; }
            const u32x4 pw = pack8(f); bw[ks] = *(const bf16x8*)&pw; }
    }
    __syncthreads();
    const int ipos = w * 16 + l15;
    const float bias = sgb[g * 128 + ipos];
    const bf16_t* urow = A1 + (tok0 + ipos) * 8192 + 6144 + g * 256;
    bf16_t* orow = A2 + (tok0 + ipos) * 3072 + 2048 + g * 256;
    for (int ct = 0; ct < 16; ++ct) {
        f32x4 acc = {0.f, 0.f, 0.f, 0.f};
#pragma unroll
        for (int ks = 0; ks < 4; ++ks) acc = mfma16(ldfrag(L, ct * 16 + l15, 272, ks * 64 + quad * 16), bw[ks], acc);
        const int c = ct * 16 + quad * 4;
        const u32x2 uw = *(const u32x2*)(urow + c);
        const float u0 = gelu_tanh(bf_lo(uw.x)), u1 = gelu_tanh(bf_hi(uw.x)), u2 = gelu_tanh(bf_lo(uw.y)), u3 = gelu_tanh(bf_hi(uw.y));
        u32x2 ow; ow.x = cvt_pk_bf16(u0 * (acc[0] + bias), u1 * (acc[1] + bias)); ow.y = cvt_pk_bf16(u2 * (acc[2] + bias), u3 * (acc[3] + bias));
        if (ABL_SG) { ow.x = 0u; ow.y = 0u; }
        *(u32x2*)(orow + c) = ow;
    }
}

__device__ void ret_finalize(int WAVE_S, const bf16_t* __restrict__ A1, bf16_t* __restrict__ A2, const bf16_t* __restrict__ RETB, const float* __restrict__ rg) {
    const int tid_ = opaque_tid(); const int lane = tid_ & 63, wave = tid_ >> 6;
#pragma unroll 2
    for (int v = blockIdx.x * 8 + wave; v < T_TOK * 4; v += gridDim.x * 8) {
        const size_t tok = (size_t)(v >> 2); const int h = v & 3; const int col = h * 512 + lane * 8;
        float r[8], g[8];
        {   const int bb = (int)(tok >> 12), sidx = (int)(tok & 4095);
            unpack8(*(const u32x4*)(RETB + ((size_t)((bb * 4 + h) * 16 + (lane >> 2)) * SEQ + sidx) * 32 + (lane & 3) * 8), r); }
        unpack8(*(const u32x4*)(A1 + tok * 8192 + 4096 + col), g);
        float ss = 0.f;
#pragma unroll
        for (int i = 0; i < 8; ++i) ss += r[i] * r[i];
        ss = wave_sum(ss);
        const float rs = rsqrtf(ss * (1.f / 512.f) + EPS);
        const f32x4 g0 = *(const f32x4*)(rg + col), g1 = *(const f32x4*)(rg + col + 4);
#pragma unroll
        for (int i = 0; i < 8; ++i) { const float gi = (i < 4) ? g0[i & 3] : g1[i & 3]; const float sl = g[i] / (1.f + __expf(-g[i])); r[i] = sl * r[i] * rs * gi; }
        if (ABL_RET) { for (int i = 0; i < 8; ++i) r[i] = 0.f; }
        *(u32x4*)(A2 + tok * 3072 + col) = pack8(r);
    }
}

__device__ void xa_item(int WAVE_S, LAS unsigned char* L, const bf16_t* __restrict__ QX, const bf16_t* __restrict__ KVX, const bf16_t* __restrict__ XVT, bf16_t* __restrict__ AO, int item) {
    constexpr int KC = 0, PS = 69632;
    const int qb = item & 31, h = (item >> 5) & 3, b = item >> 7;
    const int tid = opaque_tid(), lane = tid & 63, w = tid >> 6, l15 = lane & 15, quad = lane >> 4;
    const size_t tokw = (size_t)b * SEQ + qb * 128 + w * 16;
    const bf16_t* qrow = QX + (tokw + l15) * 2048 + h * 512;
    const bf16_t* kbase = KVX + (size_t)b * 256 * 4096 + h * 512;
    const bf16_t* vbase = XVT + (size_t)(b * 4 + h) * 512 * 256;
    f32x4 acc[16];
#pragma unroll
    for (int k = 0; k < 16; ++k) acc[k] = (f32x4){0.f, 0.f, 0.f, 0.f};
    float qss = 0.f;
    u32x4 rg[8];
#define XA_KLOAD(dc_) do { _Pragma("unroll") for (int i = 0; i < 8; ++i) { const int idx = tid + NTHR * i; rg[i] = *(const u32x4*)(kbase + (size_t)(idx >> 4) * 4096 + (dc_) * 128 + (idx & 15) * 8); } } while (0)
#define XA_VLOAD(ec_) do { _Pragma("unroll") for (int i = 0; i < 8; ++i) { const int idx = tid + NTHR * i; rg[i] = *(const u32x4*)(vbase + (size_t)((ec_) * 128 + (idx >> 5)) * 256 + (idx & 31) * 8); } } while (0)
    XA_KLOAD(0);
#pragma unroll 1
    for (int dc = 0; dc < 4; ++dc) {
        __syncthreads();
#pragma unroll
        for (int i = 0; i < 8; ++i) { const int idx = tid + NTHR * i; *(LAS u32x4*)(L + KC + (idx >> 4) * 272 + (idx & 15) * 16) = rg[i]; }
        __syncthreads();
        if (dc < 3) XA_KLOAD(dc + 1); else XA_VLOAD(0);
#pragma unroll
        for (int ks = 0; ks < 4; ++ks) {
            const u32x4 qa = *(const u32x4*)(qrow + dc * 128 + ks * 32 + quad * 8);
            { float f[8]; unpack8(qa, f);
#pragma unroll
              for (int i = 0; i < 8; ++i) qss += f[i] * f[i]; }
            const bf16x8 a = *(const bf16x8*)&qa;
#pragma unroll
            for (int kt = 0; kt < 16; ++kt) acc[kt] = mfma16(a, ldfrag(L + KC, kt * 16 + l15, 272, ks * 64 + quad * 16), acc[kt]);
        }
    }
    qss += __shfl_xor(qss, 16); qss += __shfl_xor(qss, 32);
    const float rq = rsqrtf(qss * (1.f / 512.f) + EPS) * 0.044194173824159216f;
    float inv[4];
#pragma unroll
    for (int r = 0; r < 4; ++r) {
        const float sc = __shfl(rq, quad * 4 + r);
        float mx = -1e30f;
#pragma unroll
        for (int kt = 0; kt < 16; ++kt) { acc[kt][r] *= sc; mx = fmaxf(mx, acc[kt][r]); }
        mx = fmaxf(mx, __shfl_xor(mx, 1)); mx = fmaxf(mx, __shfl_xor(mx, 2)); mx = fmaxf(mx, __shfl_xor(mx, 4)); mx = fmaxf(mx, __shfl_xor(mx, 8));
        float sm = 0.f;
#pragma unroll
        for (int kt = 0; kt < 16; ++kt) { const float p = __expf(acc[kt][r] - mx); acc[kt][r] = p; sm += p; }
        sm += __shfl_xor(sm, 1); sm += __shfl_xor(sm, 2); sm += __shfl_xor(sm, 4); sm += __shfl_xor(sm, 8);
        inv[r] = 1.f / sm;
    }
    LAS unsigned char* Pw = L + PS + w * 8448;
#pragma unroll
    for (int kt = 0; kt < 16; ++kt)
#pragma unroll
        for (int r = 0; r < 4; ++r) ((LAS bf16_t*)(Pw + (quad * 4 + r) * 528))[kt * 16 + l15] = f2bf(acc[kt][r]);
    __syncthreads();
    bf16x8 pa[8];
#pragma unroll
    for (int ks = 0; ks < 8; ++ks) pa[ks] = ldfrag(Pw, l15, 528, ks * 64 + quad * 16);
    bf16_t* orow = AO + tokw * 2048 + h * 512;
#pragma unroll 1
    for (int ec = 0; ec < 4; ++ec) {
        __syncthreads();
#pragma unroll
        for (int i = 0; i < 8; ++i) { const int idx = tid + NTHR * i; *(LAS u32x4*)(L + KC + (idx >> 5) * 528 + (idx & 31) * 16) = rg[i]; }
        __syncthreads();
        if (ec < 3) XA_VLOAD(ec + 1);
#pragma unroll
        for (int et = 0; et < 8; ++et) {
            f32x4 o = {0.f, 0.f, 0.f, 0.f};
#pragma unroll
            for (int ks = 0; ks < 8; ++ks) o = mfma16(pa[ks], ldfrag(L + KC, et * 16 + l15, 528, ks * 64 + quad * 16), o);
#pragma unroll
            for (int r = 0; r < 4; ++r) orow[(size_t)(quad * 4 + r) * 2048 + ec * 128 + et * 16 + l15] = f2bf(o[r] * inv[r]);
        }
    }
#undef XA_KLOAD
#undef XA_VLOAD
    __syncthreads();
}

__device__ void diff_prep(int WAVE_S, bf16_t* A1, const int* __restrict__ pos, const float* __restrict__ qg, const float* __restrict__ kg) {
    const int gt = blockIdx.x * NTHR + opaque_tid();
    const int sub = gt & 7; const int i0 = sub * 8;
    float gq1[8], gq2[8], gk1[8], gk2[8];
#pragma unroll
    for (int i = 0; i < 8; ++i) { gq1[i] = qg[i0 + i]; gq2[i] = qg[64 + i0 + i]; gk1[i] = kg[i0 + i]; gk2[i] = kg[64 + i0 + i]; }
#pragma unroll 1
    for (int tok = gt >> 3; tok < T_TOK; tok += (gridDim.x * NTHR) >> 3) {
        const float p = (float)pos[tok];
        float cs[8], sn[8];
#pragma unroll
        for (int i = 0; i < 8; ++i) { const float inv = exp2f(-(float)(i0 + i) * (LOG2_THETA / 64.f)); fast_sincos(p * inv, &sn[i], &cs[i]); }
        bf16_t* row = A1 + (size_t)tok * 6144;
#pragma unroll 4
        for (int v = 0; v < 32; ++v) {
            bf16_t* x = row + (v < 16 ? 0 : 2048) + (v & 15) * 128;
            float x1[8], x2[8], y1[8], y2[8];
            unpack8(*(const u32x4*)(x + i0), x1); unpack8(*(const u32x4*)(x + 64 + i0), x2);
            float ss = 0.f;
#pragma unroll
            for (int i = 0; i < 8; ++i) ss += x1[i] * x1[i] + x2[i] * x2[i];
            ss += __shfl_xor(ss, 1); ss += __shfl_xor(ss, 2); ss += __shfl_xor(ss, 4);
            const float rs = rsqrtf(ss * (1.f / 128.f) + EPS);
#pragma unroll
            for (int i = 0; i < 8; ++i) { const float a = x1[i] * rs * (v < 16 ? gq1[i] : gk1[i]), c = x2[i] * rs * (v < 16 ? gq2[i] : gk2[i]);
                y1[i] = a * cs[i] - c * sn[i]; y2[i] = c * cs[i] + a * sn[i]; }
            *(u32x4*)(x + i0) = pack8(y1); *(u32x4*)(x + 64 + i0) = pack8(y2);
        }
    }
}

__device__ void diff_post(int WAVE_S, const bf16_t* __restrict__ P0, const bf16_t* __restrict__ P1, bf16_t* __restrict__ DO, const float* __restrict__ sg,
                          const float* __restrict__ lq1, const float* __restrict__ lk1, const float* __restrict__ lq2, const float* __restrict__ lk2) {
    const float lambda_init = 0.8f - 0.6f * 0.7408182206817179f;
    const int tid_ = opaque_tid(); const int lane = tid_ & 63;
    float d1 = lq1[lane] * lk1[lane] + lq1[lane + 64] * lk1[lane + 64], d2 = lq2[lane] * lk2[lane] + lq2[lane + 64] * lk2[lane + 64];
    d1 = wave_sum(d1); d2 = wave_sum(d2);
    const float lam = expf(d1) - expf(d2) + lambda_init;
    const int gt = blockIdx.x * NTHR + tid_;
    const int sub = gt & 31; float g[8];
#pragma unroll
    for (int i = 0; i < 8; ++i) g[i] = sg[sub * 8 + i] * (1.f - lambda_init);
    const size_t nvec = (size_t)T_TOK * 8;
#pragma unroll 2
    for (size_t v = gt >> 5; v < nvec; v += (size_t)(gridDim.x * NTHR) >> 5) {
        const size_t off = v * 256 + sub * 8;
        float a[8], c[8]; unpack8(*(const u32x4*)(P0 + off), a); unpack8(*(const u32x4*)(P1 + off), c);
        float ss = 0.f;
#pragma unroll
        for (int i = 0; i < 8; ++i) { a[i] = a[i] - lam * c[i]; ss += a[i] * a[i]; }
        ss += __shfl_xor(ss, 16); ss += __shfl_xor(ss, 8); ss += __shfl_xor(ss, 4); ss += __shfl_xor(ss, 2); ss += __shfl_xor(ss, 1);
        const float rs = rsqrtf(ss * (1.f / 256.f) + EPS);
#pragma unroll
        for (int i = 0; i < 8; ++i) a[i] = a[i] * rs * g[i];
        *(u32x4*)(DO + off) = pack8(a);
    }
}


__device__ __forceinline__ void chk_report(unsigned* flag, float val, float got) {
    const float rel = fabsf(val - got) / (fabsf(val) + 0.25f);
    atomicMax(flag, __float_as_uint(rel));
    if (rel > 0.05f) atomicAdd(flag + 1, 1u);
}
__device__ void check_ret(int WAVE_S, const bf16_t* A1, const bf16_t* A2, unsigned* flag) {
    const int tid = opaque_tid(), lane = tid & 63, wave = tid >> 6;
    const int s = blockIdx.x * 8 + wave;
    const int b = s & 3, h = (s >> 2) & 3, n = (s * 977 + 13) & 4095, e = (s * 131) & 511;
    const float lg = log2f(1.f - exp2f(-5.f - (float)h));
    const bf16_t* qrow = A1 + ((size_t)b * SEQ + n) * 8192 + h * 256;
    const int cn = n >> 6; float accA = 0.f, accB = 0.f;
    for (int m = lane; m < (cn + 1) * 64; m += 64) {
        const bf16_t* krow = A1 + ((size_t)b * SEQ + m) * 8192 + 1024 + h * 256;
        float d = 0.f;
        for (int k = 0; k < 256; ++k) d += bf2f(qrow[k]) * bf2f(krow[k]);
        const float v = bf2f(A1[((size_t)b * SEQ + m) * 8192 + 2048 + h * 512 + e]);
        if ((m >> 6) == cn) accA += exp2f(lg * fabsf((float)(n - m))) * d * v; else accB += exp2f(lg * (float)(n - m)) * d * v;
    }
    accA = wave_sum(accA); accB = wave_sum(accB);
    if (lane == 0) {
        const float got = bf2f(A2[((size_t)b * SEQ + n) * 3072 + h * 512 + e]);
        if (CHKALT == 3) { const float val = (RETPART == 1) ? accA : (RETPART == 2) ? accB : accA + accB; const float rel = fabsf(val - got) / (fabsf(val) + 0.25f); if (rel > 0.05f) atomicAdd(flag + 1, 1u); }
        if (CHKALT == 2) { const float val = accA + exp2f(lg * 64.f) * accB; const float rel = fabsf(val - got) / (fabsf(val) + 0.25f); if (rel > 0.05f) atomicAdd(flag + 1, 1u); }
        if (CHKALT == 1 && fabsf(accA) > 2.f) { atomicAdd((float*)(flag + 2), (got - accB) / accA); atomicAdd(flag + 1, 1u); }
    }
}
__device__ void check_sg(int WAVE_S, const bf16_t* A1, const bf16_t* A2, const float* sgn, const float* sgw, const float* sgb, unsigned* flag) {
    const int tid = opaque_tid(), lane = tid & 63, wave = tid >> 6;
    const int s = blockIdx.x * 8 + wave;
    const int b = s & 3, g = (s >> 2) & 3, n = (s * 977 + 13) & 4095, c = (s * 131) & 255;
    const int i = n & 127; const size_t tok0 = (size_t)b * SEQ + (n & ~127);
    float acc = 0.f;
    for (int j = lane; j < 128; j += 64) {
        const bf16_t* vr = A1 + (tok0 + j) * 8192 + 7168 + g * 256; float ss = 0.f;
        for (int k = 0; k < 256; ++k) { const float x = gelu_tanh(bf2f(vr[k])); ss += x * x; }
        const float vn = gelu_tanh(bf2f(vr[c])) * rsqrtf(ss * (1.f / 256.f) + EPS) * sgn[g * 256 + c];
        const bool keep = (j >> 6) <= (i >> 6);
        acc += keep ? sgw[((size_t)g * 128 + i) * 128 + j] * vn : 0.f;
    }
    acc = wave_sum(acc);
    const float u = gelu_tanh(bf2f(A1[(tok0 + i) * 8192 + 6144 + g * 256 + c]));
    if (lane == 0) chk_report(flag, u * (acc + sgb[g * 128 + i]), bf2f(A2[(tok0 + i) * 3072 + 2048 + g * 256 + c]));
}
__device__ void check_xa(int WAVE_S, const bf16_t* QX, const bf16_t* KVX, const bf16_t* XVT, const bf16_t* AO, unsigned* flag) {
    const int tid = opaque_tid(), lane = tid & 63, wave = tid >> 6;
    const int s = blockIdx.x * 8 + wave;
    const int b = s & 3, h = (s >> 2) & 3, n = (s * 977 + 13) & 4095, e = (s * 131) & 511;
    const bf16_t* q = QX + ((size_t)b * SEQ + n) * 2048 + h * 512;
    float qs = 0.f; for (int k = 0; k < 512; ++k) qs += bf2f(q[k]) * bf2f(q[k]);
    const float rq = rsqrtf(qs * (1.f / 512.f) + EPS) * 0.044194173824159216f;
    float sc[4], mx = -1e30f;
    for (int t = 0; t < 4; ++t) { const int key = lane + 64 * t; const bf16_t* kr = KVX + ((size_t)b * 256 + key) * 4096 + h * 512; float d = 0.f;
        for (int k = 0; k < 512; ++k) d += bf2f(q[k]) * bf2f(kr[k]);
        sc[t] = d * rq; mx = fmaxf(mx, sc[t]); }
    for (int o = 32; o; o >>= 1) mx = fmaxf(mx, __shfl_xor(mx, o));
    float sm = 0.f, ov = 0.f;
    for (int t = 0; t < 4; ++t) { const int key = lane + 64 * t; const float p = __expf(sc[t] - mx); sm += p; ov += p * bf2f(XVT[((size_t)(b * 4 + h) * 512 + e) * 256 + key]); }
    sm = wave_sum(sm); ov = wave_sum(ov);
    if (lane == 0) chk_report(flag, ov / sm, bf2f(AO[((size_t)b * SEQ + n) * 2048 + h * 512 + e]));
}
__device__ void check_diff(int WAVE_S, const bf16_t* A1, const bf16_t* P0, const bf16_t* P1, unsigned* flag) {
    const int tid = opaque_tid(), lane = tid & 63, wave = tid >> 6;
    const int s = blockIdx.x * 8 + wave;
    const int b = s & 3, h = (s >> 2) & 7, m = (s >> 5) & 1, n = (s * 977 + 13) & 4095, e = (s * 131) & 255;
    const bf16_t* q = A1 + ((size_t)b * SEQ + n) * 6144 + h * 256 + m * 128;
    const int nk = ((n >> 6) + 1) * 64;
    float mx = -1e30f;
    for (int key = lane; key < nk; key += 64) { const bf16_t* kr = A1 + ((size_t)b * SEQ + key) * 6144 + 2048 + h * 256 + m * 128; float d = 0.f;
        for (int k = 0; k < 128; ++k) d += bf2f(q[k]) * bf2f(kr[k]);
        mx = fmaxf(mx, d * 0.088388347648318440f); }
    for (int o = 32; o; o >>= 1) mx = fmaxf(mx, __shfl_xor(mx, o));
    float sm = 0.f, ov = 0.f;
    for (int key = lane; key < nk; key += 64) { const bf16_t* kr = A1 + ((size_t)b * SEQ + key) * 6144 + 2048 + h * 256 + m * 128; float d = 0.f;
        for (int k = 0; k < 128; ++k) d += bf2f(q[k]) * bf2f(kr[k]);
        const float p = __expf(d * 0.088388347648318440f - mx); sm += p; ov += p * bf2f(A1[((size_t)b * SEQ + key) * 6144 + 4096 + h * 256 + e]); }
    sm = wave_sum(sm); ov = wave_sum(ov);
    if (lane == 0) chk_report(flag, ov / sm, bf2f((m ? P1 : P0)[((size_t)b * SEQ + n) * 2048 + h * 256 + e]));
}


__device__ __forceinline__ void grid_barrier(int WAVE_S, unsigned* bar, unsigned k  ) {
    asm volatile("s_waitcnt vmcnt(0)" ::: "memory");
    __syncthreads();
    if (opaque_tid() == 0) {
        __builtin_amdgcn_fence(__ATOMIC_RELEASE, "agent");
        const unsigned x = blockIdx.x & 7u;
        const unsigned old = __hip_atomic_fetch_add(bar + 64 * x, 1u, __ATOMIC_RELAXED, __HIP_MEMORY_SCOPE_AGENT);
        if (old + 1u == 32u * k) {
            const unsigned old2 = __hip_atomic_fetch_add(bar + 64 * 8, 1u, __ATOMIC_RELAXED, __HIP_MEMORY_SCOPE_AGENT);
            if (old2 + 1u == 8u * k) __hip_atomic_store(bar + 64 * 9, k, __ATOMIC_RELAXED, __HIP_MEMORY_SCOPE_AGENT);
        }
        while (__hip_atomic_load(bar + 64 * 9, __ATOMIC_RELAXED, __HIP_MEMORY_SCOPE_AGENT) < k) __builtin_amdgcn_s_sleep(1);
        __builtin_amdgcn_fence(__ATOMIC_ACQUIRE, "agent");
    }
    __syncthreads();
}

#ifndef EN_CVT_WEIGHT
#define EN_CVT_WEIGHT 1
#endif
#ifndef EN_RMSNORM_ROWS
#define EN_RMSNORM_ROWS 1
#endif
#ifndef EN_L0_PREP_ITEM
#define EN_L0_PREP_ITEM 1
#endif
#ifndef EN_XA_PREP_ITEM
#define EN_XA_PREP_ITEM 1
#endif
#ifndef EN_RET_FINALIZE
#define EN_RET_FINALIZE 1
#endif
#ifndef EN_DIFF_PREP
#define EN_DIFF_PREP 1
#endif
#ifndef EN_DIFF_POST
#define EN_DIFF_POST 1
#endif
#ifndef EN_GEMM
#define EN_GEMM 1
#endif
#ifndef EN_ATT
#define EN_ATT 1
#endif
#ifndef EN_RET
#define EN_RET 1
#endif
#ifndef EN_SG
#define EN_SG 1
#endif
#ifndef EN_XA
#define EN_XA 1
#endif
#ifndef EN_MISC
#define EN_MISC 1
#endif
__global__ void __launch_bounds__(NTHR, 2) mk(Params p) {
    extern __shared__ __attribute__((aligned(16))) unsigned char lds_raw[];
    LAS unsigned char* L = (LAS unsigned char*)lds_raw;
    const int WAVE_S = __builtin_amdgcn_readfirstlane((int)(threadIdx.x >> 6));
    cg::grid_group grid = cg::this_grid();
    unsigned char* ws = p.ws;
#define X (p.out)
#define W ((bf16_t*)(p.ws + OFF_W))
#define A1 ((bf16_t*)(p.ws + OFF_A1))
#define A2 ((bf16_t*)(p.ws + OFF_A2))
#define A3 ((bf16_t*)(p.ws + OFF_A3))
#define KVX ((bf16_t*)(p.ws + OFF_KVX))
#define XVT ((bf16_t*)(p.ws + OFF_XVT))
#define MEMN ((bf16_t*)(p.ws + OFF_MEMN))
#define SSQ ((float*)(p.ws + OFF_SSQ))
#define XS ((bf16_t*)(p.ws + OFF_XS))
#define W2KV ((bf16_t*)(p.ws + OFF_W2KV))
#define KVX2 ((bf16_t*)(p.ws + OFF_KVX2))
#define XVT2 ((bf16_t*)(p.ws + OFF_XVT2))
#define MEMN2 ((bf16_t*)(p.ws + OFF_MEMN2))
#define KT ((bf16_t*)(p.ws + OFF_KT))
#define RETB ((bf16_t*)(p.ws + OFF_RET))
    const int G = gridDim.x, bid = blockIdx.x;
    const int lo = p.ph_lo, hi = p.ph_hi;
    int ph = 0; unsigned nbar = 0;
#define PHASE_BEGIN if (lo <= ph && ph < hi) {
#define PHASE_END   if (ph + 1 < hi) { if (ph == lo) grid.sync(); else { ++nbar; grid_barrier(WAVE_S, (unsigned*)(p.ws + OFF_SSQ), nbar); } } } ++ph;
#define INF(k) ((const float*)p.in[k])

#define SSQK(k) ((float*)(p.ws + OFF_SSQ + 4096) + (size_t)(k) * T_TOK)
    for (int li = 0; li < 2; ++li) {
#define n_xa (INF(4) + li * 2048)
#define n_mem (INF(5) + li * 2048)
#define n_ffn (INF(6) + li * 2048)
#define n_mix (INF(3) + li * 2048)
#define wXQ (li ? W1_XQ : W0_XQ)
#define wXKV (li ? W1_XKV : W0_XKV)
#define wXO (li ? W1_XO : W0_XO)
#define wF1 (li ? W1_F1 : W0_F1)
#define wF2 (li ? W1_F2 : W0_F2)
        if (li == 0) {
            PHASE_BEGIN
                cvt_weight(WAVE_S, L, INF(23), W + W0_XKV, 2048, 4096);
                cvt_weight(WAVE_S, L, INF(23) + (size_t)2048 * 4096, W2KV, 2048, 4096);
                rmsnorm_rows(WAVE_S, INF(1), INF(5), MEMN, nullptr, 1024);
                rmsnorm_rows(WAVE_S, INF(1), INF(5) + 2048, MEMN2, nullptr, 1024);
            PHASE_END
            PHASE_BEGIN
                if (bid < 64) pg8::run_gemm(WAVE_S, L, MEMN, W + W0_XKV, 1024, 4096, 2048, pg8::EpiBf16<0>{KVX, 4096, nullptr}, bid);
                else if (bid < 128) pg8::run_gemm(WAVE_S, L, MEMN2, W2KV, 1024, 4096, 2048, pg8::EpiBf16<0>{KVX2, 4096, nullptr}, bid - 64);
                else { cvt_weight(WAVE_S, L, INF(22), W + W0_XQ, 2048, 2048, n_xa, bid - 128, 128);
                       cvt_weight(WAVE_S, L, INF(26), W + W0_XO, 2048, 2048, nullptr, bid - 128, 128);
                       cvt_weight(WAVE_S, L, INF(12), W + W0_OUT, 3072, 2048, nullptr, bid - 128, 128); }
                cvt_weight(WAVE_S, L, INF(7), W + W0_IN, 2048, 8192);
                cvt_weight(WAVE_S, L, INF(27), W + W0_F1, 2048, 8192, n_ffn);
                cvt_weight(WAVE_S, L, INF(28), W + W0_F2, 8192, 2048);
                rmsnorm_rows(WAVE_S, INF(0), n_mix, A2, nullptr, T_TOK);
            PHASE_END
        } else {
            PHASE_BEGIN
                cvt_weight(WAVE_S, L, INF(13), W + W1_QKV, 2048, 6144, n_mix); cvt_weight(WAVE_S, L, INF(21), W + W1_O, 2048, 2048);
                cvt_weight(WAVE_S, L, INF(22) + (size_t)2048 * 2048, W + W1_XQ, 2048, 2048, n_xa);
                cvt_weight(WAVE_S, L, INF(26) + (size_t)2048 * 2048, W + W1_XO, 2048, 2048);
                cvt_weight(WAVE_S, L, INF(27) + (size_t)2048 * 8192, W + W1_F1, 2048, 8192, n_ffn);
                cvt_weight(WAVE_S, L, INF(28) + (size_t)8192 * 2048, W + W1_F2, 8192, 2048);
            PHASE_END
        }
        if (li == 0) {
            PHASE_BEGIN
                pg8::run_gemm(WAVE_S, L, A2, W + W0_IN, T_TOK, 8192, 2048, pg8::EpiBf16<0>{A1, 8192, nullptr});
            PHASE_END
            PHASE_BEGIN
                for (int it = bid; it < 1024; it += G) l0_prep_item(WAVE_S, L, A1, (const int*)p.in[2], KT, A3, it);
                for (int it = bid; it < 128; it += G) { if (it < 64) xa_prep_item(WAVE_S, L, KVX, XVT, INF(25), INF(24), it); else xa_prep_item(WAVE_S, L, KVX2, XVT2, INF(25) + 512, INF(24) + 512, it - 64); }
            PHASE_END
            PHASE_BEGIN
                {   const int gq = bid >> 4, bhq = bid & 15;
                    for (int k = 0; k < 4; ++k) { const int cq = (k & 1) ? (63 - 16 * k - 15 + gq) : (63 - 16 * k - gq); retention_quad_item(WAVE_S, L, A1, A3, A2, INF(8), bhq, cq); } }
                for (int it = bid; it < 512; it += G) sg_item(WAVE_S, L, A1, A2, INF(9), INF(10), INF(11), it);
            PHASE_END
            PHASE_BEGIN
                pg8::run_gemm(WAVE_S, L, A2, W + W0_OUT, T_TOK, 2048, 3072, pg8::EpiStream<0>{INF(0), XS, SSQK(0), nullptr, 2048});
            PHASE_END
        } else {
            PHASE_BEGIN
                pg8::run_gemm(WAVE_S, L, XS, W + W1_QKV, T_TOK, 6144, 2048, pg8::EpiBf16<0>{A1, 6144, SSQK(2)});
            PHASE_END
            PHASE_BEGIN
                diff_prep(WAVE_S, A1, (const int*)p.in[2], INF(14), INF(15));
            PHASE_END
            PHASE_BEGIN
                for (int k = 0; k < 2048 / 256; ++k) {
                    const int i = k * G + bid; if (i >= 2048) break;
                    const int half = (bid >= 128) ? 1 : 0; const int pick = (k & 1) ? (1 - half) : half;
                    const int qbl = 15 - (2 * k + pick); const int rest = bid & 127;
                    const int vh = rest & 1, m = (rest >> 1) & 1, h = (rest >> 2) & 7, b = rest >> 5;
                    const bf16_t* base = A1 + (size_t)b * SEQ * 6144;
                    bf16_t* PO = m ? A3 : (A1 + (size_t)T_TOK * 6144);
                    __syncthreads();
                    att::attn_body(WAVE_S, base + (size_t)qbl * 256 * 6144 + h * 256 + m * 128, base + 2048 + h * 256 + m * 128, base + 4096 + h * 256 + vh * 128,
                                   PO + ((size_t)b * SEQ + qbl * 256) * 2048 + h * 256 + vh * 128, (qbl + 1) * 256, (char*)lds_raw);
                }
                __syncthreads();
            PHASE_END
            PHASE_BEGIN
                diff_post(WAVE_S, A1 + (size_t)T_TOK * 6144, A3, A2, INF(20), INF(16), INF(17), INF(18), INF(19));
            PHASE_END
            PHASE_BEGIN
                pg8::run_gemm(WAVE_S, L, A2, W + W1_O, T_TOK, 2048, 2048, pg8::EpiStream<1>{nullptr, XS, SSQK(3), nullptr, 2048});
            PHASE_END
        }
        PHASE_BEGIN
            pg8::run_gemm(WAVE_S, L, XS, W + wXQ, T_TOK, 2048, 2048, pg8::EpiBf16<0>{A3, 2048, SSQK(li ? 3 : 0)});
        PHASE_END
        PHASE_BEGIN
            for (int it = bid; it < 512; it += G) xa_item(WAVE_S, L, A3, li ? KVX2 : KVX, li ? XVT2 : XVT, A2, it);
        PHASE_END
        PHASE_BEGIN
            pg8::run_gemm(WAVE_S, L, A2, W + wXO, T_TOK, 2048, 2048, pg8::EpiStream<1>{nullptr, XS, SSQK(li ? 4 : 1), nullptr, 2048});
        PHASE_END
        PHASE_BEGIN
            pg8::run_gemm(WAVE_S, L, XS, W + wF1, T_TOK, 8192, 2048, pg8::EpiBf16<1>{A1, 8192, SSQK(li ? 4 : 1)});
        PHASE_END
        PHASE_BEGIN
            if (li == 0) pg8::run_gemm(WAVE_S, L, A1, W + wF2, T_TOK, 2048, 8192, pg8::EpiStream<1>{nullptr, XS, SSQK(2), nullptr, 2048});
            else pg8::run_gemm(WAVE_S, L, A1, W + wF2, T_TOK, 2048, 8192, pg8::EpiStream<2>{nullptr, XS, nullptr, X, 2048});
        PHASE_END
    }
}

#undef SSQK
#undef XS
#undef W2KV
#undef KVX2
#undef XVT2
#undef MEMN2
#undef W
#undef A1
#undef A2
#undef A3
#undef KVX
#undef XVT
#undef MEMN
#undef KT
#undef RETB
#undef SSQ
#undef X
#undef n_xa
#undef n_mem
#undef n_ffn
#undef n_mix
#undef wXQ
#undef wXKV
#undef wXO
#undef wF1
#undef wF2
__global__ void __launch_bounds__(NTHR) chk_kernel(Params p) {
    const int WAVE_S = (int)(threadIdx.x >> 6);
    unsigned char* ws = p.ws;
    bf16_t* A1 = (bf16_t*)(ws + OFF_A1); bf16_t* A2 = (bf16_t*)(ws + OFF_A2); bf16_t* A3 = (bf16_t*)(ws + OFF_A3);
    bf16_t* KVX = (bf16_t*)(ws + OFF_KVX); bf16_t* XVT = (bf16_t*)(ws + OFF_XVT); unsigned* flag = (unsigned*)(ws + OFF_SSQ + 4096);
    if (CHK == 1) check_ret(WAVE_S, A1, A2, flag);
    if (CHK == 2) check_sg(WAVE_S, A1, A2, (const float*)p.in[9], (const float*)p.in[10], (const float*)p.in[11], flag);
    if (CHK == 3) check_xa(WAVE_S, A3, KVX, XVT, A2, flag);
    if (CHK == 4) check_diff(WAVE_S, A1, A1 + (size_t)T_TOK * 6144, A3, flag);
}
__global__ void chk_final(float* X, unsigned* flag) { const unsigned c = atomicAdd(flag + 1, 0u); X[0] = 1e5f * (float)((c + 32u) >> 6); }
__global__ void chk_zero(unsigned* flag) { if (threadIdx.x < 8) atomicExch(flag + threadIdx.x, 0u); }

#ifndef MK_PER_PHASE
#define MK_PER_PHASE 0
#endif
constexpr int N_PHASES = 22;
extern "C" void kernel_launch(void* const* d_in, const int* in_sizes, int n_in, void* d_out, int out_size, void* d_ws, size_t ws_size, hipStream_t stream) {
    static int grid = 0;
    if (grid == 0) {
        if (n_in != 29 || out_size != T_TOK * DM || ws_size < WS_END) { fprintf(stderr, "kernel_launch: unexpected shapes n_in %d out %d ws %zu (need %zu)\n", n_in, out_size, ws_size, (size_t)WS_END); grid = -1; return; }
        int dev = 0, cus = 0, per_cu = 0;
        hipGetDevice(&dev); hipDeviceGetAttribute(&cus, hipDeviceAttributeMultiprocessorCount, dev);
        if (hipFuncSetAttribute((const void*)mk, hipFuncAttributeMaxDynamicSharedMemorySize, LDS_BYTES) != hipSuccess) { fprintf(stderr, "kernel_launch: hipFuncSetAttribute failed\n"); grid = -1; return; }
        if (hipOccupancyMaxActiveBlocksPerMultiprocessor(&per_cu, (const void*)mk, NTHR, LDS_BYTES) != hipSuccess || per_cu < 1) { fprintf(stderr, "kernel_launch: occupancy query says %d\n", per_cu); per_cu = 1; }
        (void)hipGetLastError();
        grid = cus * 1;
        if (grid > 256) grid = 256;
        if (grid != 256) { fprintf(stderr, "kernel_launch: this kernel is laid out for 256 workgroups (one per CU of a 256-CU device); found %d CUs\n", cus); grid = -1; return; }
    }
    if (grid < 0) return;
    Params p{};
    for (int i = 0; i < 29; ++i) p.in[i] = d_in[i];
    p.out = (float*)d_out; p.ws = (unsigned char*)d_ws;
#if MK_PER_PHASE
    for (int k = 0; k < N_PHASES; ++k) { p.ph_lo = k; p.ph_hi = k + 1; hipLaunchKernelGGL(mk, dim3(grid), dim3(NTHR), LDS_BYTES, stream, p);
        if (CHK && k == 0) hipLaunchKernelGGL(chk_zero, dim3(1), dim3(64), 0, stream, (unsigned*)((char*)d_ws + OFF_SSQ + 4096));
        if (((CHK == 1 || CHK == 2) && k == 3) || (CHK == 3 && k == 8) || (CHK == 4 && k == 16)) hipLaunchKernelGGL(chk_kernel, dim3(256), dim3(NTHR), 0, stream, p); }
    if (CHK) hipLaunchKernelGGL(chk_final, dim3(1), dim3(1), 0, stream, (float*)d_out, (unsigned*)((char*)d_ws + OFF_SSQ + 4096));
#else
    p.ph_lo = 0; p.ph_hi = N_PHASES;
    (void)hipMemsetAsync((char*)d_ws + OFF_SSQ, 0, 4096 + 5 * T_TOK * 4, stream);
    void* args[] = {&p};
    hipError_t e = hipLaunchCooperativeKernel((const void*)mk, dim3(grid), dim3(NTHR), args, LDS_BYTES, stream);
    if (e != hipSuccess) fprintf(stderr, "cooperative launch failed: %s (grid %d)\n", hipGetErrorString(e), grid);
#endif
}
```

```cpp
#include <hip/hip_runtime.h>
#include <hip/hip_cooperative_groups.h>
#include <cstdio>
#include <cstdint>
namespace cg = cooperative_groups;

#ifndef CHK
#define CHK 0
#endif
#ifndef CHKALT
#define CHKALT 0
#endif
#ifndef RETPART
#define RETPART 0
#endif
#ifndef DBL_GEMM
#define DBL_GEMM 0
#endif
#ifndef DBL_ATT
#define DBL_ATT 0
#endif
#ifndef DBL_RET
#define DBL_RET 0
#endif
#ifndef DBL_CVT
#define DBL_CVT 0
#endif
#ifndef DBL_MISC
#define DBL_MISC 0
#endif
#ifndef RET_NAIVE
#define RET_NAIVE 0
#endif
#ifndef NAIVE_SRC
#define NAIVE_SRC 0
#endif
#ifndef ABL_SG
#define ABL_SG 0
#endif
#ifndef ABL_RET
#define ABL_RET 0
#endif
#ifndef ABL_XA
#define ABL_XA 0
#endif
#ifndef ABL_DIFF
#define ABL_DIFF 0
#endif
#define LAS __attribute__((address_space(3)))
typedef unsigned short bf16_t;
typedef short bf16x8 __attribute__((ext_vector_type(8)));
typedef short s16x4 __attribute__((ext_vector_type(4)));
typedef float f32x2 __attribute__((ext_vector_type(2)));
typedef float f32x4 __attribute__((ext_vector_type(4)));
typedef float f32x16 __attribute__((ext_vector_type(16)));
typedef unsigned u32x2 __attribute__((ext_vector_type(2)));
typedef unsigned u32x4 __attribute__((ext_vector_type(4)));

constexpr int T_TOK = 16384, DM = 2048, SEQ = 4096, NB = 4;
constexpr float EPS = 1e-6f;
constexpr float LOG2_THETA = 13.287712379549449f;
constexpr int NTHR = 512;
constexpr int LDS_BYTES = 155648;

constexpr size_t MiB = 1048576;
constexpr size_t OFF_W = 0;
constexpr size_t OFF_A1 = 140 * MiB;
constexpr size_t OFF_A2 = 396 * MiB;
constexpr size_t OFF_A3 = 492 * MiB;
constexpr size_t OFF_KVX = 556 * MiB;
constexpr size_t OFF_XVT = 564 * MiB;
constexpr size_t OFF_MEMN = 568 * MiB;
constexpr size_t OFF_SSQ = 572 * MiB;
constexpr size_t OFF_KT = 576 * MiB;
constexpr size_t OFF_RET = 608 * MiB;
constexpr size_t OFF_XS = 576 * MiB;
constexpr size_t OFF_W2KV = OFF_A1;
constexpr size_t OFF_MEMN2 = OFF_A1 + 16 * MiB;
constexpr size_t OFF_KVX2 = 640 * MiB;
constexpr size_t OFF_XVT2 = 648 * MiB;
constexpr size_t WS_END = 652 * MiB;

constexpr size_t W0_IN = 0;
constexpr size_t W0_OUT = W0_IN + (size_t)8192 * 2048;
constexpr size_t W0_XQ = W0_OUT + (size_t)2048 * 3072;
constexpr size_t W0_XKV = W0_XQ + (size_t)2048 * 2048;
constexpr size_t W0_XO = W0_XKV + (size_t)4096 * 2048;
constexpr size_t W0_F1 = W0_XO + (size_t)2048 * 2048;
constexpr size_t W0_F2 = W0_F1 + (size_t)8192 * 2048;
constexpr size_t W1_QKV = 0;
constexpr size_t W1_O = W1_QKV + (size_t)6144 * 2048;
constexpr size_t W1_XQ = W1_O + (size_t)2048 * 2048;
constexpr size_t W1_XKV = W1_XQ + (size_t)2048 * 2048;
constexpr size_t W1_XO = W1_XKV + (size_t)4096 * 2048;
constexpr size_t W1_F1 = W1_XO + (size_t)2048 * 2048;
constexpr size_t W1_F2 = W1_F1 + (size_t)8192 * 2048;

__device__ __forceinline__ unsigned cvt_pk_bf16(float lo, float hi) { unsigned r; asm("v_cvt_pk_bf16_f32 %0, %1, %2" : "=v"(r) : "v"(lo), "v"(hi)); return r; }
__device__ __forceinline__ float bf_lo(unsigned w) { return __uint_as_float(w << 16); }
__device__ __forceinline__ float bf_hi(unsigned w) { return __uint_as_float(w & 0xffff0000u); }
__device__ __forceinline__ bf16_t f2bf(float f) { return (bf16_t)(cvt_pk_bf16(f, 0.f) & 0xffffu); }
__device__ __forceinline__ float bf2f(bf16_t h) { return __uint_as_float(((unsigned)h) << 16); }
__device__ __forceinline__ void unpack8(u32x4 w, float* f) { f[0] = bf_lo(w.x); f[1] = bf_hi(w.x); f[2] = bf_lo(w.y); f[3] = bf_hi(w.y); f[4] = bf_lo(w.z); f[5] = bf_hi(w.z); f[6] = bf_lo(w.w); f[7] = bf_hi(w.w); }
__device__ __forceinline__ u32x4 pack8(const float* f) { u32x4 w; w.x = cvt_pk_bf16(f[0], f[1]); w.y = cvt_pk_bf16(f[2], f[3]); w.z = cvt_pk_bf16(f[4], f[5]); w.w = cvt_pk_bf16(f[6], f[7]); return w; }
__device__ __forceinline__ float wave_sum(float v) { v += __shfl_xor(v, 32); v += __shfl_xor(v, 16); v += __shfl_xor(v, 8); v += __shfl_xor(v, 4); v += __shfl_xor(v, 2); v += __shfl_xor(v, 1); return v; }
__device__ __forceinline__ float gelu_tanh(float x) { const float u = 0.7978845608028654f * (x + 0.044715f * x * x * x); const float t = 1.f - 2.f / (1.f + __expf(2.f * u)); return 0.5f * x * (1.f + t); }
__device__ __forceinline__ void fast_sincos(float ang, float* s, float* c) { float t = ang * 0.15915494309189535f; t -= rintf(t); *s = __builtin_amdgcn_sinf(t); *c = __builtin_amdgcn_cosf(t); }
__device__ __forceinline__ f32x4 mfma16(bf16x8 a, bf16x8 b, f32x4 c) { return __builtin_amdgcn_mfma_f32_16x16x32_bf16(a, b, c, 0, 0, 0); }
__device__ __forceinline__ int opaque_tid_(int wave_s) { int t; asm volatile("v_mbcnt_lo_u32_b32 %0, -1, 0\n\tv_mbcnt_hi_u32_b32 %0, -1, %0\n\tv_lshl_or_b32 %0, %1, 6, %0" : "=&v"(t) : "s"(wave_s)); return t; }
#define opaque_tid() opaque_tid_(WAVE_S)
__device__ __forceinline__ bf16x8 ldfrag(LAS unsigned char* base, int row, int stride, int kbyte) { return *(LAS bf16x8*)(base + row * stride + kbyte); }

namespace pg8 {
constexpr int BM = 256, BK = 64, HALF = 128, HTB = HALF * BK * 2, STAGE_BYTES = 8 * HTB, NXCD = 8, WGM = 8;
__host__ __device__ __forceinline__ int lds_byte(int r, int c) { const int st = (r >> 4) * 2 + (c >> 5), rr = r & 15, cc = c & 31, ob = rr * 64 + cc * 2; return st * 1024 + (ob ^ (((ob >> 9) & 1) << 5)); }
__host__ __device__ __forceinline__ void stage_rc(int b, int& R, int& C) { const int st = b / 1024, sb = b % 1024, swz = sb ^ (((sb >> 9) & 1) << 5); R = (st >> 1) * 16 + swz / 64; C = (st & 1) * 32 + (swz % 64) / 2; }
__host__ __device__ __forceinline__ int perm32(int rho) { const int n = rho >> 4, i = rho & 15; return 8 * (i >> 2) + 4 * n + (i & 3); }
struct Unit { int pm, pn; };
struct Gemm { const bf16_t* A; const bf16_t* Bt; int M, N, K; };
struct StaticOrder {
    int nM, nN, nwg, G, c;
    __device__ void init(int M, int N, int G_, int c_) { nM = M / BM; nN = N / BM; nwg = nM * nN; G = G_; c = c_; }
    __device__ bool next(int i, Unit& u) const {
        const long L = (long)i * G + c; if (L >= nwg) return false;
        int wgid = (int)L; { const int q = nwg / NXCD, r = nwg % NXCD, xcd = wgid % NXCD, off = wgid / NXCD; wgid = (xcd < r ? xcd * (q + 1) : r * (q + 1) + (xcd - r) * q) + off; }
        const int nig = WGM * nN, gid = wgid / nig, fm = gid * WGM, gsz = (nM - fm) < WGM ? (nM - fm) : WGM;
        u.pm = fm + ((wgid % nig) % gsz); u.pn = (wgid % nig) / gsz; return true;
    }
    __device__ __forceinline__ void a_ready(const Unit&) const {}
    __device__ __forceinline__ void done(const Unit&) const {}
};
__device__ __forceinline__ float ssq_read(const float* p) { return __hip_atomic_load((float*)p, __ATOMIC_RELAXED, __HIP_MEMORY_SCOPE_AGENT); }
template <int ACT  > struct EpiBf16 {
    static constexpr bool PERM = true;
    bf16_t* O; int ldc; const float* ssq;
    __device__ __forceinline__ void operator()(const f32x4 (&acc)[2][2][4][2], const Unit& u, int wr, int wc, int fr, int fq) const {
        const int row0 = u.pm * BM + wr * 64 + fr; const int col0 = u.pn * BM + wc * 32 + 8 * fq;
#pragma unroll
        for (int ai = 0; ai < 2; ++ai)
#pragma unroll
            for (int m = 0; m < 4; ++m) { bf16_t* rowp = O + (size_t)(row0 + ai * HALF + m * 16) * ldc + col0;
                const float rs = ssq ? rsqrtf(ssq_read(ssq + row0 + ai * HALF + m * 16) * (1.f / 2048.f) + EPS) : 1.f;
#pragma unroll
                for (int bj = 0; bj < 2; ++bj) { f32x4 v0 = acc[ai][bj][m][0] * rs, v1 = acc[ai][bj][m][1] * rs;
                    if (ACT == 1) {
#pragma unroll
                        for (int j = 0; j < 4; ++j) { float a = fmaxf(v0[j], 0.f), b = fmaxf(v1[j], 0.f); v0[j] = a * a; v1[j] = b * b; } }
                    u32x4 w; w.x = cvt_pk_bf16(v0[0], v0[1]); w.y = cvt_pk_bf16(v0[2], v0[3]); w.z = cvt_pk_bf16(v1[0], v1[1]); w.w = cvt_pk_bf16(v1[2], v1[3]);
                    *(u32x4*)(rowp + bj * HALF) = w; } }
    }
};
template <int MODE> struct EpiStream {
    static constexpr bool PERM = false;
    const float* Xin; bf16_t* XS; float* ssq; float* Out; int ldc;
    __device__ __forceinline__ void operator()(const f32x4 (&acc)[2][2][4][2], const Unit& u, int wr, int wc, int fr, int fq) const {
        const int row0 = u.pm * BM + wr * 64 + fr, col0 = u.pn * BM + wc * 32 + 4 * fq;
#pragma unroll
        for (int ai = 0; ai < 2; ++ai)
#pragma unroll
            for (int m = 0; m < 4; ++m) { const size_t roff = (size_t)(row0 + ai * HALF + m * 16) * ldc + col0; float ss = 0.f;
#pragma unroll
                for (int bj = 0; bj < 2; ++bj)
#pragma unroll
                    for (int n = 0; n < 2; ++n) { const size_t o = roff + bj * HALF + n * 16; f32x4 v;
                        if (MODE == 0) v = *(const f32x4*)(Xin + o);
                        else { const u32x2 xw = *(const u32x2*)(XS + o); v = (f32x4){bf_lo(xw.x), bf_hi(xw.x), bf_lo(xw.y), bf_hi(xw.y)}; }
                        v = v + acc[ai][bj][m][n];
                        if (MODE == 2) *(f32x4*)(Out + o) = v;
                        else { ss += v[0] * v[0] + v[1] * v[1] + v[2] * v[2] + v[3] * v[3];
                            u32x2 w; w.x = cvt_pk_bf16(v[0], v[1]); w.y = cvt_pk_bf16(v[2], v[3]); *(u32x2*)(XS + o) = w; } }
                if (MODE != 2) { ss += __shfl_xor(ss, 16); ss += __shfl_xor(ss, 32);
                    if (fq == 0) atomicAdd(ssq + row0 + ai * HALF + m * 16, ss); }
                asm volatile("" ::: "memory"); }
    }
};
struct EpiResF32 {
    static constexpr bool PERM = false;
    float* C; int ldc;
    __device__ __forceinline__ void operator()(const f32x4 (&acc)[2][2][4][2], const Unit& u, int wr, int wc, int fr, int fq) const {
        const int row0 = u.pm * BM + wr * 64 + fr, col0 = u.pn * BM + wc * 32 + 4 * fq;
#pragma unroll
        for (int ai = 0; ai < 2; ++ai)
#pragma unroll
            for (int m = 0; m < 4; ++m) { float* rowp = C + (size_t)(row0 + ai * HALF + m * 16) * ldc + col0;
#pragma unroll
                for (int bj = 0; bj < 2; ++bj)
#pragma unroll
                    for (int n = 0; n < 2; ++n) { f32x4* p = (f32x4*)(rowp + bj * HALF + n * 16); *p = *p + acc[ai][bj][m][n]; }
                asm volatile("" ::: "memory"); }
    }
};

template <class Epi, class Sched>
__device__ __forceinline__ void gemm_phase(int WAVE_S, LAS unsigned char* lds, const Gemm g, const Sched& S, const Epi& E) {
    const int tid = opaque_tid(), wid = __builtin_amdgcn_readfirstlane(tid >> 6), lane = tid & 63, wr = wid >> 2, wc = wid & 3, fr = lane & 15, fq = lane >> 4;
    const int K = g.K, nt = K / BK;
    unsigned voffA[2], voffB[2];
#pragma unroll
    for (int i = 0; i < 2; ++i) { int R, C; stage_rc(tid * 16 + i * 8192, R, C); const int Rb = Epi::PERM ? ((R & ~31) + perm32(R & 31)) : R;
        voffA[i] = (unsigned)(R * K + C) * 2u; voffB[i] = (unsigned)(Rb * K + C) * 2u; }
    const size_t kstep = (size_t)(BK * 2);
    const size_t hstep = (size_t)HALF * K * 2;
    const size_t tstep = 2 * hstep;
    const unsigned ldsw = (unsigned)wid * 1024u;
    const int aoff = lds_byte(wr * 64 + fr, fq * 8), boff = lds_byte(wc * 32 + fr, fq * 8);
#define PG8_SA(b, h) (((b) * 2 + (h)) * HTB)
#define PG8_SB(b, h) ((4 + (b) * 2 + (h)) * HTB)
#define PG8_STAGE(bufoff, gbase, voff) do { _Pragma("unroll") for (int _i = 0; _i < 2; ++_i) \
        __builtin_amdgcn_global_load_lds((const unsigned*)((const char*)(gbase) + (voff)[_i]), (LAS unsigned*)(lds + (bufoff) + ldsw + _i * 8192), 16, 0, 0); } while (0)
#define PG8_LDA(dst, b, h) do { _Pragma("unroll") for (int m = 0; m < 4; ++m) _Pragma("unroll") for (int k = 0; k < 2; ++k) dst[m][k] = *(const LAS bf16x8*)(lds + PG8_SA(b, h) + aoff + m * 2048 + k * 1024); } while (0)
#define PG8_LDB(dst, b, h) do { _Pragma("unroll") for (int n = 0; n < 2; ++n) _Pragma("unroll") for (int k = 0; k < 2; ++k) dst[n][k] = *(const LAS bf16x8*)(lds + PG8_SB(b, h) + boff + n * 2048 + k * 1024); } while (0)
#define PG8_MMA(ai, bj, At, Bt) do { __builtin_amdgcn_s_setprio(1); _Pragma("unroll") for (int m = 0; m < 4; ++m) _Pragma("unroll") for (int n = 0; n < 2; ++n) _Pragma("unroll") for (int k = 0; k < 2; ++k) \
        acc[ai][bj][m][n] = __builtin_amdgcn_mfma_f32_16x16x32_bf16(Bt[n][k], At[m][k], acc[ai][bj][m][n], 0, 0, 0); __builtin_amdgcn_s_setprio(0); } while (0)
#define PG8_WAIT_V(n) asm volatile("s_waitcnt vmcnt(" #n ")" ::: "memory")
#define PG8_WAIT_L(n) asm volatile("s_waitcnt lgkmcnt(" #n ")" ::: "memory")
#define PG8_BAR __builtin_amdgcn_s_barrier()
#define PG8_SCHED __builtin_amdgcn_sched_barrier(0)
    Unit cur, nxt; int ui = 0;
    if (!S.next(0, cur)) return;
    f32x4 acc[2][2][4][2];
#pragma unroll
    for (int a = 0; a < 2; ++a)
#pragma unroll
        for (int b = 0; b < 2; ++b)
#pragma unroll
            for (int m = 0; m < 4; ++m)
#pragma unroll
                for (int n = 0; n < 2; ++n) acc[a][b][m][n] = (f32x4){0.f, 0.f, 0.f, 0.f};
    bf16x8 At[4][2], B0[2][2], B1[2][2];
    const char* cA = (const char*)g.A + (size_t)cur.pm * tstep; const char* cB = (const char*)g.Bt + (size_t)cur.pn * tstep;
    S.a_ready(cur);
    PG8_STAGE(PG8_SB(0, 0), cB, voffB); PG8_STAGE(PG8_SA(0, 0), cA, voffA); PG8_STAGE(PG8_SB(0, 1), cB + hstep, voffB); PG8_STAGE(PG8_SA(0, 1), cA + hstep, voffA);
    if (wr == 1) PG8_BAR;
    PG8_WAIT_V(4); PG8_BAR;
    PG8_STAGE(PG8_SB(1, 0), cB + kstep, voffB); PG8_STAGE(PG8_SA(1, 0), cA + kstep, voffA); PG8_STAGE(PG8_SB(1, 1), cB + hstep + kstep, voffB);
    PG8_WAIT_V(6); PG8_BAR;
    for (;;) {
        const bool has_next = S.next(ui + 1, nxt);
        const char* nA = has_next ? (const char*)g.A + (size_t)nxt.pm * tstep : cA; const char* nB = has_next ? (const char*)g.Bt + (size_t)nxt.pn * tstep : cB;
        for (int t = 0; t < nt; t += 2) {
            const bool last = (t == nt - 2);
            const char* a1 = cA + (size_t)(t + 1) * kstep;
            const char* a2 = last ? nA : cA + (size_t)(t + 2) * kstep; const char* b2 = last ? nB : cB + (size_t)(t + 2) * kstep;
            const char* a3 = a2 + kstep; const char* b3 = b2 + kstep;
            if (last && has_next) S.a_ready(nxt);
            PG8_LDB(B0, 0, 0); PG8_SCHED; PG8_LDA(At, 0, 0); PG8_STAGE(PG8_SA(1, 1), a1 + hstep, voffA);
            PG8_WAIT_L(8); PG8_BAR; PG8_WAIT_L(0); PG8_MMA(0, 0, At, B0); PG8_BAR; PG8_SCHED;
            PG8_LDB(B1, 0, 1); PG8_STAGE(PG8_SB(0, 0), b2, voffB);
            PG8_BAR; PG8_WAIT_L(0); PG8_MMA(0, 1, At, B1); PG8_BAR;
            PG8_LDA(At, 0, 1); PG8_STAGE(PG8_SA(0, 0), a2, voffA);
            PG8_BAR; PG8_WAIT_L(0); PG8_MMA(1, 0, At, B0); PG8_BAR; PG8_SCHED;
            PG8_STAGE(PG8_SB(0, 1), b2 + hstep, voffB);
            PG8_WAIT_V(6); PG8_BAR; PG8_MMA(1, 1, At, B1); PG8_BAR;
            PG8_LDB(B0, 1, 0); PG8_SCHED; PG8_LDA(At, 1, 0); PG8_STAGE(PG8_SA(0, 1), a2 + hstep, voffA);
            PG8_WAIT_L(8); PG8_BAR; PG8_WAIT_L(0); PG8_MMA(0, 0, At, B0); PG8_BAR; PG8_SCHED;
            PG8_LDB(B1, 1, 1); PG8_STAGE(PG8_SB(1, 0), b3, voffB);
            PG8_BAR; PG8_WAIT_L(0); PG8_MMA(0, 1, At, B1); PG8_BAR;
            PG8_LDA(At, 1, 1); PG8_STAGE(PG8_SA(1, 0), a3, voffA);
            PG8_BAR; PG8_WAIT_L(0); PG8_MMA(1, 0, At, B0); PG8_BAR; PG8_SCHED;
            PG8_STAGE(PG8_SB(1, 1), b3 + hstep, voffB);
            PG8_WAIT_V(6); PG8_BAR; PG8_MMA(1, 1, At, B1); PG8_BAR;
        }
        E(acc, cur, wr, wc, fr, fq); S.done(cur);
        if (!has_next) break;
#pragma unroll
        for (int a = 0; a < 2; ++a)
#pragma unroll
            for (int b = 0; b < 2; ++b)
#pragma unroll
                for (int m = 0; m < 4; ++m)
#pragma unroll
                    for (int n = 0; n < 2; ++n) acc[a][b][m][n] = (f32x4){0.f, 0.f, 0.f, 0.f};
        cur = nxt; cA = nA; cB = nB; ++ui;
    }
    PG8_WAIT_V(0);
    if (wr == 0) PG8_BAR;
    PG8_BAR;
#undef PG8_SA
#undef PG8_SB
#undef PG8_STAGE
#undef PG8_LDA
#undef PG8_LDB
#undef PG8_MMA
#undef PG8_WAIT_V
#undef PG8_WAIT_L
#undef PG8_BAR
#undef PG8_SCHED
}
template <class Epi>
__device__ __forceinline__ void run_gemm(int WAVE_S, LAS unsigned char* lds, const bf16_t* A, const bf16_t* Bt, int M, int N, int K, const Epi& E, int vb = -1) {
    Gemm g{A, Bt, M, N, K}; StaticOrder S; S.init(M, N, (int)gridDim.x, vb < 0 ? (int)blockIdx.x : vb);
    gemm_phase<Epi, StaticOrder>(WAVE_S, lds, g, S, E);
    __syncthreads();
}
}

namespace att {
constexpr int D = 128, NW = 8, QBLK = 32, KVBLK = 64;
constexpr float SCALE = 0.088388347648318440f;
constexpr float THR = 8.f;
constexpr int SHM_V = KVBLK * D * 2, SHM_K = KVBLK * D * 2, SHM_ATTN = 2 * SHM_V + 2 * SHM_K + NW * 64 * 4;
#define KSWZ(row, colB) ((row) * 256 + ((colB) ^ (((row) & 7) << 4)))
#define SBAR() __builtin_amdgcn_sched_barrier(0)
__device__ __forceinline__ int crow(int r, int hi) { return (r & 3) + 8 * (r >> 2) + 4 * hi; }
__device__ __forceinline__ unsigned cvtpk(float lo, float hi) { unsigned r; asm volatile("v_cvt_pk_bf16_f32 %0, %1, %2" : "=v"(r) : "v"(lo), "v"(hi)); return r; }
__device__ __forceinline__ void partialSM(f32x16& p0, f32x16& p1, float& m_reg, float& mn, float& alpha, bool masked) {
  constexpr float C = SCALE * 1.4426950408889634f;
  if (masked) {
#pragma unroll
    for (int r = 0; r < 16; ++r) { p0[r] = -1e30f; p1[r] = -1e30f; } }
  float pmax = p0[0];
#pragma unroll
  for (int r = 1; r < 16; ++r) pmax = fmaxf(pmax, p0[r]);
#pragma unroll
  for (int r = 0; r < 16; ++r) pmax = fmaxf(pmax, p1[r]);
  { auto rr = __builtin_amdgcn_permlane32_swap(__float_as_uint(pmax), __float_as_uint(pmax), false, false);
    pmax = fmaxf(__uint_as_float(rr[0]), __uint_as_float(rr[1])); }
  if (__builtin_expect(__all(pmax - m_reg <= THR / SCALE), 1)) { mn = m_reg; alpha = 1.f; }
  else { mn = fmaxf(m_reg, pmax); alpha = __builtin_amdgcn_exp2f((m_reg - mn) * C); m_reg = mn; }
  float mnC = -mn * C;
#pragma unroll
  for (int r = 0; r < 16; ++r) p0[r] = fmaf(p0[r], C, mnC);
#pragma unroll
  for (int r = 0; r < 16; ++r) p1[r] = fmaf(p1[r], C, mnC);
#pragma unroll
  for (int r = 0; r < 16; ++r) p0[r] = __builtin_amdgcn_exp2f(p0[r]);
}
__device__ __forceinline__ void finishSM(f32x16& p0, f32x16& p1, float alpha, float& l_reg, bf16x8& pa0, bf16x8& pa1, bf16x8& pa2, bf16x8& pa3) {
#pragma unroll
  for (int r = 0; r < 16; ++r) p1[r] = __builtin_amdgcn_exp2f(p1[r]);
  float ps = 0;
#pragma unroll
  for (int r = 0; r < 16; ++r) ps += p0[r];
#pragma unroll
  for (int r = 0; r < 16; ++r) ps += p1[r];
  { auto rr = __builtin_amdgcn_permlane32_swap(__float_as_uint(ps), __float_as_uint(ps), false, false);
    ps = __uint_as_float(rr[0]) + __uint_as_float(rr[1]); }
  l_reg = l_reg * alpha + ps;
#define PK4(P, BASE, OUT) do { unsigned a0 = cvtpk(P[BASE + 0], P[BASE + 1]), a1 = cvtpk(P[BASE + 2], P[BASE + 3]);   \
    unsigned b0 = cvtpk(P[BASE + 4], P[BASE + 5]), b1 = cvtpk(P[BASE + 6], P[BASE + 7]);                              \
    auto r0 = __builtin_amdgcn_permlane32_swap(a0, b0, false, false); auto r1 = __builtin_amdgcn_permlane32_swap(a1, b1, false, false); \
    u32x4 w = {r0[0], r1[0], r0[1], r1[1]}; OUT = *reinterpret_cast<bf16x8*>(&w); } while (0)
  PK4(p0, 0, pa0); PK4(p0, 8, pa1); PK4(p1, 0, pa2); PK4(p1, 8, pa3);
#undef PK4
}
__device__ __forceinline__ void qkt(f32x16& p0, f32x16& p1, const bf16_t* Ks, const bf16x8* qr, int r32, int hi) {
  p0 = f32x16{}; p1 = f32x16{};
#pragma unroll
  for (int d0 = 0; d0 < 8; ++d0) { int cb = (d0 * 16 + hi * 8) * 2;
    bf16x8 b0 = *reinterpret_cast<const bf16x8*>((const char*)Ks + KSWZ(r32, cb));
    bf16x8 b1 = *reinterpret_cast<const bf16x8*>((const char*)Ks + KSWZ(32 + r32, cb));
    p0 = __builtin_amdgcn_mfma_f32_32x32x16_bf16(b0, qr[d0], p0, 0, 0, 0);
    p1 = __builtin_amdgcn_mfma_f32_32x32x16_bf16(b1, qr[d0], p1, 0, 0, 0); }
}
__device__ __forceinline__ int v_st(int k, int c) { const int kk = (k & ~0xC) | ((k & 4) << 1) | ((k & 8) >> 1); return ((kk >> 3) * 4 + (c >> 5)) * 512 + ((kk & 7) * 32 + (c & 31)) * 2; }
__device__ __forceinline__ int v_rd_base(int lane) { return ((lane & 3) << 3) | (((lane >> 2) & 3) << 6) | (((lane >> 4) & 1) << 5) | (((lane >> 5) & 1) << 8); }
constexpr int v_rd_off(int d0, int ks, int half) { return d0 * 512 + ks * 4096 + half * 2048; }
template <int OFF> __device__ __forceinline__ s16x4 tr_read(int vb) {
  s16x4 r; asm volatile("ds_read_b64_tr_b16 %0, %1 offset:%2" : "=&v"(r) : "v"(vb), "i"(OFF) : "memory"); return r;
}
template <int D0> __device__ __forceinline__ void pv_one(f32x16& od, int vb, bf16x8 pa0, bf16x8 pa1, bf16x8 pa2, bf16x8 pa3) {
  const s16x4 l0 = tr_read<v_rd_off(D0, 0, 0)>(vb), h0 = tr_read<v_rd_off(D0, 0, 1)>(vb), l1 = tr_read<v_rd_off(D0, 1, 0)>(vb), h1 = tr_read<v_rd_off(D0, 1, 1)>(vb);
  const s16x4 l2 = tr_read<v_rd_off(D0, 2, 0)>(vb), h2 = tr_read<v_rd_off(D0, 2, 1)>(vb), l3 = tr_read<v_rd_off(D0, 3, 0)>(vb), h3 = tr_read<v_rd_off(D0, 3, 1)>(vb);
  asm volatile("s_waitcnt lgkmcnt(0)" ::: "memory"); SBAR();
#define PK(L, H) (bf16x8){L[0], L[1], L[2], L[3], H[0], H[1], H[2], H[3]}
  od = __builtin_amdgcn_mfma_f32_32x32x16_bf16(pa0, PK(l0, h0), od, 0, 0, 0);
  od = __builtin_amdgcn_mfma_f32_32x32x16_bf16(pa1, PK(l1, h1), od, 0, 0, 0);
  od = __builtin_amdgcn_mfma_f32_32x32x16_bf16(pa2, PK(l2, h2), od, 0, 0, 0);
  od = __builtin_amdgcn_mfma_f32_32x32x16_bf16(pa3, PK(l3, h3), od, 0, 0, 0);
#undef PK
}
__device__ __forceinline__ void pv_d0(f32x16* o, int vb, bf16x8 pa0, bf16x8 pa1, bf16x8 pa2, bf16x8 pa3) {
  pv_one<0>(o[0], vb, pa0, pa1, pa2, pa3); pv_one<1>(o[1], vb, pa0, pa1, pa2, pa3); pv_one<2>(o[2], vb, pa0, pa1, pa2, pa3); pv_one<3>(o[3], vb, pa0, pa1, pa2, pa3);
}
constexpr int LDR = 6144, LDO = 2048;
__device__ __forceinline__ void attn_body(int WAVE_S, const bf16_t* __restrict__ Qb, const bf16_t* __restrict__ Kh, const bf16_t* __restrict__ Vh,
                                          bf16_t* __restrict__ Ob, int seq, char* lds) {
  const int tid = opaque_tid(), wid = tid >> 6, lane = tid & 63, r32 = lane & 31, hi = lane >> 5;
  bf16_t* V_lds = (bf16_t*)lds; bf16_t* K_lds = (bf16_t*)(lds + 2 * SHM_V);
  float* ws = (float*)(lds + 2 * SHM_V + 2 * SHM_K) + wid * 64; float* li_l = ws; float* al_l = ws + 32;
  float m_reg = -1e30f, l_reg = 0; f32x16 o[4] = {}; bf16x8 qr[8];
  const bf16_t* Qw = Qb + (long)(wid * QBLK + r32) * LDR + hi * 8;
#pragma unroll
  for (int d0 = 0; d0 < 8; ++d0) qr[d0] = *reinterpret_cast<const bf16x8*>(Qw + d0 * 16);
  const int sr = tid >> 4, sc = (tid & 15) * 8, vst0 = v_st(sr, sc), vst1 = v_st(32 + sr, sc);
  const int vb0 = (int)(uintptr_t)V_lds + v_rd_base(lane);
  struct { bf16x8 vs0, vs1, ks0, ks1; } sr_[2];
#define SLOAD(i, k0) do { sr_[i].vs0 = *reinterpret_cast<const bf16x8*>(&Vh[(long)((k0) + sr) * LDR + sc]); sr_[i].vs1 = *reinterpret_cast<const bf16x8*>(&Vh[(long)((k0) + 32 + sr) * LDR + sc]); \
    sr_[i].ks0 = *reinterpret_cast<const bf16x8*>(&Kh[(long)((k0) + sr) * LDR + sc]); sr_[i].ks1 = *reinterpret_cast<const bf16x8*>(&Kh[(long)((k0) + 32 + sr) * LDR + sc]); } while (0)
#define SWRITE(b, i) do { *(bf16x8*)((char*)V_lds + (b) * SHM_V + vst0) = sr_[i].vs0;          \
    *(bf16x8*)((char*)V_lds + (b) * SHM_V + vst1) = sr_[i].vs1; int kc = sc * 2;               \
    *(bf16x8*)((char*)K_lds + (b) * SHM_K + KSWZ(sr, kc)) = sr_[i].ks0;                       \
    *(bf16x8*)((char*)K_lds + (b) * SHM_K + KSWZ(32 + sr, kc)) = sr_[i].ks1; } while (0)
#define SWAIT() asm volatile("s_waitcnt vmcnt(4)" ::: "memory")
#define RESC(a) do { if (__any((a) < 1.f)) { if (hi == 0) al_l[r32] = (a); asm volatile("s_waitcnt lgkmcnt(0)" ::: "memory"); \
    for (int d = 0; d < 4; ++d) for (int r = 0; r < 16; ++r) o[d][r] *= al_l[crow(r, hi)]; } } while (0)
  f32x16 pA0, pA1, pB0, pB1; float mnA, mnB, alA, alB; bf16x8 pa0, pa1, pa2, pa3; const int NT = seq / KVBLK;
  const int last_vis = NT - 4 + (wid >> 1);
  constexpr int SE = 0, SO = 1;
  SLOAD(SE, 0); asm volatile("s_waitcnt vmcnt(0)" ::: "memory"); SWRITE(0, SE); __syncthreads();
  qkt(pA0, pA1, K_lds, qr, r32, hi); partialSM(pA0, pA1, m_reg, mnA, alA, false);
  SLOAD(SO, KVBLK); if (2 < NT) SLOAD(SE, 2 * KVBLK);
  SWAIT(); SWRITE(1, SO); __syncthreads();
  for (int j = 1; j + 1 < NT; j += 2) {
    SBAR(); qkt(pB0, pB1, (bf16_t*)((char*)K_lds + SHM_K), qr, r32, hi);
    finishSM(pA0, pA1, alA, l_reg, pa0, pa1, pa2, pa3); SBAR();
    SLOAD(SO, (j + 2) * KVBLK); SBAR();
    pv_d0(o, vb0, pa0, pa1, pa2, pa3); partialSM(pB0, pB1, m_reg, mnB, alB, j > last_vis);
    __syncthreads(); SWAIT(); SWRITE(0, SE);
    RESC(alB); __syncthreads();
    SBAR(); qkt(pA0, pA1, K_lds, qr, r32, hi);
    finishSM(pB0, pB1, alB, l_reg, pa0, pa1, pa2, pa3); SBAR();
    if (j + 3 < NT) SLOAD(SE, (j + 3) * KVBLK); SBAR();
    pv_d0(o, vb0 + (int)SHM_V, pa0, pa1, pa2, pa3); partialSM(pA0, pA1, m_reg, mnA, alA, (j + 1) > last_vis);
    __syncthreads(); SWAIT(); SWRITE(1, SO);
    RESC(alA); __syncthreads();
  }
  SBAR(); qkt(pB0, pB1, (bf16_t*)((char*)K_lds + SHM_K), qr, r32, hi);
  finishSM(pA0, pA1, alA, l_reg, pa0, pa1, pa2, pa3); SBAR();
  pv_d0(o, vb0, pa0, pa1, pa2, pa3); partialSM(pB0, pB1, m_reg, mnB, alB, (NT - 1) > last_vis);
  __syncthreads(); RESC(alB);
  finishSM(pB0, pB1, alB, l_reg, pa0, pa1, pa2, pa3); SBAR();
  pv_d0(o, vb0 + (int)SHM_V, pa0, pa1, pa2, pa3);
  if (hi == 0) li_l[r32] = l_reg; asm volatile("s_waitcnt lgkmcnt(0)" ::: "memory");
  float rli[16];
#pragma unroll
  for (int r = 0; r < 16; ++r) rli[r] = __builtin_amdgcn_rcpf(li_l[crow(r, hi)]);
  bf16_t* Ow = Ob + (long)(wid * QBLK) * LDO;
#pragma unroll
  for (int r = 0; r < 16; ++r) { int orow = crow(r, hi);
#pragma unroll
    for (int d0 = 0; d0 < 4; ++d0) Ow[(long)orow * LDO + d0 * 32 + r32] = f2bf(o[d0][r] * rli[r]); }
#undef SLOAD
#undef SWRITE
#undef SWAIT
#undef RESC
}
}

struct Params { const void* in[29]; float* out; unsigned char* ws; int ph_lo, ph_hi; };

__device__ void cvt_weight(int WAVE_S, LAS unsigned char* L, const float* __restrict__ src, bf16_t* __restrict__ dst, int K, int N, const float* __restrict__ gain = nullptr, int vb = -1, int vg = 0) {
    LAS float* tile = (LAS float*)L;
    const int tid = opaque_tid();
    const int ntn = N / 64, ntiles = (K / 64) * ntn;
    const int lr = tid >> 3, lc = (tid & 7) * 8;
    f32x4 v0 = {0.f, 0.f, 0.f, 0.f}, v1 = {0.f, 0.f, 0.f, 0.f};
    if (vb < 0) { vb = blockIdx.x; vg = gridDim.x; }
    int t = vb;
    if (t < ntiles) { const int tk = t / ntn, tn = t % ntn; const float* s = src + (size_t)(tk * 64 + lr) * N + tn * 64 + lc; v0 = *(const f32x4*)s; v1 = *(const f32x4*)(s + 4); }
    for (; t < ntiles; t += vg) {
        const int tk = t / ntn, tn = t % ntn;
        const float gk = gain ? gain[tk * 64 + lr] : 1.f;
        __syncthreads();
#pragma unroll
        for (int j = 0; j < 4; ++j) { tile[lr * 65 + lc + j] = v0[j] * gk; tile[lr * 65 + lc + 4 + j] = v1[j] * gk; }
        __syncthreads();
        const int t2 = t + vg;
        if (t2 < ntiles) { const int tk2 = t2 / ntn, tn2 = t2 % ntn; const float* s = src + (size_t)(tk2 * 64 + lr) * N + tn2 * 64 + lc; v0 = *(const f32x4*)s; v1 = *(const f32x4*)(s + 4); }
        const int n = tid >> 3, kc = (tid & 7) * 8;
        float f[8];
#pragma unroll
        for (int i = 0; i < 8; ++i) f[i] = tile[(kc + i) * 65 + n];
        *(u32x4*)(dst + (size_t)(tn * 64 + n) * K + tk * 64 + kc) = pack8(f);
    }
    __syncthreads();
}

__device__ void rmsnorm_rows(int WAVE_S, const float* __restrict__ X, const float* __restrict__ gain, bf16_t* __restrict__ out, float* __restrict__ copy, int rows) {
    const int tid_ = opaque_tid(); const int lane = tid_ & 63, wave = tid_ >> 6;
#pragma unroll 1
    for (int r = blockIdx.x * 8 + wave; r < rows; r += gridDim.x * 8) {
        const float* x = X + (size_t)r * 2048;
        f32x4 v[8]; float ss = 0.f;
#pragma unroll
        for (int j = 0; j < 8; ++j) { v[j] = *(const f32x4*)(x + j * 256 + lane * 4); ss += v[j][0] * v[j][0] + v[j][1] * v[j][1] + v[j][2] * v[j][2] + v[j][3] * v[j][3]; }
        ss = wave_sum(ss);
        const float rs = rsqrtf(ss * (1.f / 2048.f) + EPS);
#pragma unroll
        for (int j = 0; j < 8; ++j) { const f32x4 g = *(const f32x4*)(gain + j * 256 + lane * 4);
            u32x2 w; w.x = cvt_pk_bf16(v[j][0] * rs * g[0], v[j][1] * rs * g[1]); w.y = cvt_pk_bf16(v[j][2] * rs * g[2], v[j][3] * rs * g[3]);
            *(u32x2*)(out + (size_t)r * 2048 + j * 256 + lane * 4) = w;
            if (copy) *(f32x4*)(copy + (size_t)r * 2048 + j * 256 + lane * 4) = v[j]; }
    }
}

__device__ __forceinline__ void transpose_store(int WAVE_S, LAS bf16_t* tile, bf16_t* __restrict__ dst, size_t ld) {
#pragma unroll 2
    for (int idx = opaque_tid(); idx < 256 * 8; idx += NTHR) { const int d = idx >> 3, sc = idx & 7;
        unsigned short e[8];
#pragma unroll
        for (int i = 0; i < 8; ++i) e[i] = tile[(sc * 8 + i) * 264 + d];
        u32x4 w; w.x = e[0] | ((unsigned)e[1] << 16); w.y = e[2] | ((unsigned)e[3] << 16); w.z = e[4] | ((unsigned)e[5] << 16); w.w = e[6] | ((unsigned)e[7] << 16);
        *(u32x4*)(dst + (size_t)d * ld + sc * 8) = w; }
}
__device__ __forceinline__ void tile_load(int WAVE_S, LAS bf16_t* tile, const bf16_t* __restrict__ src, size_t ld) {
#pragma unroll
    for (int idx = opaque_tid(); idx < 64 * 32; idx += NTHR) { const int r = idx >> 5, c = (idx & 31) * 8;
        *(LAS u32x4*)(tile + r * 264 + c) = *(const u32x4*)(src + (size_t)r * ld + c); }
}

__device__ void l0_prep_item(int WAVE_S, LAS unsigned char* L, bf16_t* A1, const int* __restrict__ pos, bf16_t* KT, bf16_t* VT, int item) {
    const int h = item & 3, c = (item >> 2) & 63, b = item >> 8;
    const int tid = opaque_tid();
    const size_t tok0 = (size_t)b * SEQ + c * 64;
    LAS bf16_t* tile = (LAS bf16_t*)L;
    __syncthreads();
#pragma unroll 2
    for (int pass = 0; pass < 2; ++pass) {
        const int s = (tid >> 4) + pass * 32, i0 = (tid & 15) * 8;
        const float p = (float)pos[tok0 + s];
        float cs[8], sn[8];
#pragma unroll
        for (int i = 0; i < 8; ++i) { const float inv = exp2f(-(float)(i0 + i) * (LOG2_THETA / 128.f)); fast_sincos(p * inv, &sn[i], &cs[i]); }
        bf16_t* row = A1 + (tok0 + s) * 8192;
        {   bf16_t* q = row + h * 256; float x1[8], x2[8], y1[8], y2[8];
            unpack8(*(const u32x4*)(q + i0), x1); unpack8(*(const u32x4*)(q + 128 + i0), x2);
#pragma unroll
            for (int i = 0; i < 8; ++i) { y1[i] = x1[i] * cs[i] - x2[i] * sn[i]; y2[i] = x2[i] * cs[i] + x1[i] * sn[i]; }
            *(u32x4*)(q + i0) = pack8(y1); *(u32x4*)(q + 128 + i0) = pack8(y2); }
        {   bf16_t* k = row + 1024 + h * 256; float x1[8], x2[8], y1[8], y2[8];
            unpack8(*(const u32x4*)(k + i0), x1); unpack8(*(const u32x4*)(k + 128 + i0), x2);
#pragma unroll
            for (int i = 0; i < 8; ++i) { y1[i] = (x1[i] * cs[i] - x2[i] * sn[i]) * 0.0625f; y2[i] = (x2[i] * cs[i] + x1[i] * sn[i]) * 0.0625f; }
            const u32x4 w1 = pack8(y1), w2 = pack8(y2);
            *(u32x4*)(k + i0) = w1; *(u32x4*)(k + 128 + i0) = w2;
            if (RET_NAIVE == 2) { *(LAS u32x4*)(tile + s * 264 + i0) = w1; *(LAS u32x4*)(tile + s * 264 + 128 + i0) = w2; } }
    }
    __syncthreads();
    if (RET_NAIVE == 2) transpose_store(WAVE_S, tile, KT + ((size_t)(b * 4 + h) * 256) * SEQ + c * 64, SEQ);
    for (int half = 0; half < 2; ++half) {
        __syncthreads();
        tile_load(WAVE_S, tile, A1 + tok0 * 8192 + 2048 + h * 512 + half * 256, 8192);
        __syncthreads();
        transpose_store(WAVE_S, tile, VT + ((size_t)(b * 4 + h) * 512 + half * 256) * SEQ + c * 64, SEQ);
    }
}

__device__ void xa_prep_item(int WAVE_S, LAS unsigned char* L, bf16_t* KVX, bf16_t* XVT, const float* __restrict__ kg, const float* __restrict__ qg, int item) {
    const int kc = item & 3, h = (item >> 2) & 3, b = item >> 4;
    const int tid = opaque_tid(), lane = tid & 63, wave = tid >> 6;
    LAS bf16_t* tile = (LAS bf16_t*)L;
    const size_t row0 = (size_t)b * 256 + kc * 64;
    float g[8];
#pragma unroll
    for (int i = 0; i < 8; ++i) g[i] = kg[lane * 8 + i] * qg[lane * 8 + i];
#pragma unroll 4
    for (int r = wave; r < 64; r += 8) {
        bf16_t* k = KVX + (row0 + r) * 4096 + h * 512 + lane * 8; float x[8];
        unpack8(*(const u32x4*)k, x); float ss = 0.f;
#pragma unroll
        for (int i = 0; i < 8; ++i) ss += x[i] * x[i];
        ss = wave_sum(ss); const float rs = rsqrtf(ss * (1.f / 512.f) + EPS);
#pragma unroll
        for (int i = 0; i < 8; ++i) x[i] = x[i] * rs * g[i];
        *(u32x4*)k = pack8(x);
    }
    for (int half = 0; half < 2; ++half) {
        __syncthreads();
        tile_load(WAVE_S, tile, KVX + row0 * 4096 + 2048 + h * 512 + half * 256, 4096);
        __syncthreads();
        transpose_store(WAVE_S, tile, XVT + ((size_t)(b * 4 + h) * 512 + half * 256) * 256 + kc * 64, 256);
    }
    __syncthreads();
}

__device__ void retention_item(int WAVE_S, LAS unsigned char* L, const bf16_t* __restrict__ A1, const bf16_t* __restrict__ KT, const bf16_t* __restrict__ VT,
                               bf16_t* __restrict__ A2, float* __restrict__ ssq, int bh, int slice) {
    constexpr int QS = 0, KS = 33792, KTS = 67584, VTS = 104448, VDS = 109056, SSO = 113664, STS = 122880;
    const int b = bh >> 2, h = bh & 3;
    const int tid = opaque_tid(), lane = tid & 63, w = tid >> 6, l15 = lane & 15, quad = lane >> 4;
    const float gamma = 1.f - exp2f(-5.f - (float)h);
    const float lg = log2f(gamma);
    __syncthreads();
    for (int i = tid; i < 16896 / 4; i += NTHR) ((LAS unsigned*)(L + STS))[i] = 0u;
    f32x4 st[2][2];
#pragma unroll
    for (int a = 0; a < 2; ++a)
#pragma unroll
        for (int e = 0; e < 2; ++e) st[a][e] = (f32x4){0.f, 0.f, 0.f, 0.f};
    const bf16_t* qb = A1 + (size_t)b * SEQ * 8192 + h * 256;
    const bf16_t* kb = qb + 1024;
    const bf16_t* ktb = KT + (size_t)bh * 256 * SEQ;
    const bf16_t* vtb = VT + ((size_t)bh * 512 + slice * 32) * SEQ;
    u32x4 rq[4], rk[4], rkt[4], rvt = {0u, 0u, 0u, 0u};
    float vdec[8];
#pragma unroll
    for (int i = 0; i < 8; ++i) vdec[i] = exp2f(lg * (float)(64 - ((tid & 7) * 8 + i)));
#define RET_GLOAD(c) do { _Pragma("unroll") for (int i = 0; i < 4; ++i) { const int p = tid + NTHR * i; const int r = p >> 5, cc = (p & 31) * 8; \
            rq[i] = *(const u32x4*)(qb + (size_t)((c) * 64 + r) * 8192 + cc); rk[i] = *(const u32x4*)(kb + (size_t)((c) * 64 + r) * 8192 + cc); \
            const int d = p >> 3, c2 = (p & 7) * 8; rkt[i] = *(const u32x4*)(ktb + (size_t)d * SEQ + (c) * 64 + c2); } \
        if (tid < 256) rvt = *(const u32x4*)(vtb + (size_t)(tid >> 3) * SEQ + (c) * 64 + (tid & 7) * 8); } while (0)
    RET_GLOAD(0);
    const int it = w >> 1, jt0 = (w & 1) * 2, et = w & 1;
    const float cd = exp2f(lg * 64.f);
    for (int c = 0; c < 64; ++c) {
        __syncthreads();
#pragma unroll
        for (int i = 0; i < 4; ++i) { const int p = tid + NTHR * i; const int r = p >> 5, cc = (p & 31) * 16;
            *(LAS u32x4*)(L + QS + r * 528 + cc) = rq[i]; *(LAS u32x4*)(L + KS + r * 528 + cc) = rk[i];
            const int d = p >> 3, c2 = (p & 7) * 16; *(LAS u32x4*)(L + KTS + d * 144 + c2) = rkt[i]; }
        if (tid < 256) { const int e = tid >> 3, c2 = (tid & 7) * 16; *(LAS u32x4*)(L + VTS + e * 144 + c2) = rvt;
            float f[8]; unpack8(rvt, f);
#pragma unroll
            for (int i = 0; i < 8; ++i) f[i] *= vdec[i];
            *(LAS u32x4*)(L + VDS + e * 144 + c2) = pack8(f); }
        __syncthreads();
        if (c + 1 < 64) RET_GLOAD(c + 1);
        f32x4 s0 = {0.f, 0.f, 0.f, 0.f}, s1 = s0, qs = s0;
#pragma unroll 2
        for (int ks = 0; ks < 8; ++ks) { const int kb_ = ks * 64 + quad * 16;
            const bf16x8 a = ldfrag(L + QS, it * 16 + l15, 528, kb_);
            const bf16x8 b0 = ldfrag(L + KS, jt0 * 16 + l15, 528, kb_);
            const bf16x8 b1 = ldfrag(L + KS, (jt0 + 1) * 16 + l15, 528, kb_);
            const bf16x8 bs = ldfrag(L + STS, et * 16 + l15, 528, kb_);
            s0 = mfma16(a, b0, s0); s1 = mfma16(a, b1, s1); qs = mfma16(a, bs, qs); }
#pragma unroll
        for (int r = 0; r < 4; ++r) { const int i = it * 16 + quad * 4 + r; const int j0 = jt0 * 16 + l15, j1 = j0 + 16;
            ((LAS bf16_t*)(L + SSO + i * 144))[j0] = f2bf(s0[r] * exp2f(lg * fabsf((float)(i - j0))));
            ((LAS bf16_t*)(L + SSO + i * 144))[j1] = f2bf(s1[r] * exp2f(lg * fabsf((float)(i - j1)))); }
        __syncthreads();
        f32x4 sv = {0.f, 0.f, 0.f, 0.f};
#pragma unroll
        for (int ks = 0; ks < 2; ++ks) { const int kb_ = ks * 64 + quad * 16;
            sv = mfma16(ldfrag(L + SSO, it * 16 + l15, 144, kb_), ldfrag(L + VTS, et * 16 + l15, 144, kb_), sv); }
        {
#pragma unroll
            for (int r = 0; r < 4; ++r) { const int i = it * 16 + quad * 4 + r;
                const float o = (RETPART == 1) ? sv[r] : (RETPART == 2) ? exp2f(lg * (float)i) * qs[r] : sv[r] + exp2f(lg * (float)i) * qs[r];
                A2[((size_t)(bh * 16 + slice) * SEQ + c * 64 + i) * 32 + et * 16 + l15] = f2bf(o); } }
#pragma unroll
        for (int dt = 0; dt < 2; ++dt)
#pragma unroll
            for (int e2 = 0; e2 < 2; ++e2) { f32x4 a = st[dt][e2] * cd;
#pragma unroll
                for (int ks = 0; ks < 2; ++ks) { const int kb_ = ks * 64 + quad * 16;
                    a = mfma16(ldfrag(L + KTS, (2 * w + dt) * 16 + l15, 144, kb_), ldfrag(L + VDS, e2 * 16 + l15, 144, kb_), a); }
                st[dt][e2] = a;
                u32x2 pk; pk.x = cvt_pk_bf16(a[0], a[1]); pk.y = cvt_pk_bf16(a[2], a[3]);
                *(LAS u32x2*)(L + STS + (e2 * 16 + l15) * 528 + ((2 * w + dt) * 16 + quad * 4) * 2) = pk; }
    }
#undef RET_GLOAD
    __syncthreads();
}


__device__ void retention_quad_item(int WAVE_S, LAS unsigned char* L, const bf16_t* __restrict__ A1, const bf16_t* __restrict__ VT, bf16_t* __restrict__ A2, const float* __restrict__ rg, int bh, int c) {
    constexpr int QS = 0, KS = 33792, VTC = 67584, SSO = 141312, RSO = 150528;
    const int b = bh >> 2, h = bh & 3;
    const int tid = opaque_tid(), lane = tid & 63, w = tid >> 6, l15 = lane & 15, quad = lane >> 4;
    const float lg = log2f(1.f - exp2f(-5.f - (float)h));
    const bf16_t* qb = A1 + ((size_t)b * SEQ + c * 64) * 8192 + h * 256;
    const bf16_t* kb0 = A1 + (size_t)b * SEQ * 8192 + 1024 + h * 256;
    const bf16_t* vtb = VT + (size_t)bh * 512 * SEQ;
    const int it = w >> 1, jt0 = (w & 1) * 2;
    const int et0 = w * 4;
    f32x4 acc[4][4];
#pragma unroll
    for (int a = 0; a < 4; ++a)
#pragma unroll
        for (int t = 0; t < 4; ++t) acc[a][t] = (f32x4){0.f, 0.f, 0.f, 0.f};
    u32x4 rk[4], rv[8];
#define RQ_KLOAD(cp_) do { _Pragma("unroll") for (int i = 0; i < 4; ++i) { const int p = tid + NTHR * i; rk[i] = *(const u32x4*)(kb0 + (size_t)((cp_) * 64 + (p >> 5)) * 8192 + (p & 31) * 8); } } while (0)
#define RQ_VLOAD(cp_) do { _Pragma("unroll") for (int i = 0; i < 8; ++i) { const int p = tid + NTHR * i; rv[i] = *(const u32x4*)(vtb + (size_t)(p >> 3) * SEQ + (cp_) * 64 + (p & 7) * 8); } } while (0)
#define RQ_KWRITE() do { _Pragma("unroll") for (int i = 0; i < 4; ++i) { const int p = tid + NTHR * i; *(LAS u32x4*)(L + KS + (p >> 5) * 528 + (p & 31) * 16) = rk[i]; } } while (0)
    RQ_KLOAD(0); RQ_VLOAD(0);
    {   u32x4 rq[4];
#pragma unroll
        for (int i = 0; i < 4; ++i) { const int p = tid + NTHR * i; rq[i] = *(const u32x4*)(qb + (size_t)(p >> 5) * 8192 + (p & 31) * 8); }
        __syncthreads();
#pragma unroll
        for (int i = 0; i < 4; ++i) { const int p = tid + NTHR * i; *(LAS u32x4*)(L + QS + (p >> 5) * 528 + (p & 31) * 16) = rq[i]; }
        RQ_KWRITE();
        if (c >= 1) RQ_KLOAD(1); }
#pragma unroll 1
    for (int cp = 0; cp <= c; ++cp) {
        __syncthreads();
#pragma unroll
        for (int i = 0; i < 8; ++i) { const int p = tid + NTHR * i; *(LAS u32x4*)(L + VTC + (p >> 3) * 144 + (p & 7) * 16) = rv[i]; }
        if (cp < c) RQ_VLOAD(cp + 1);
        f32x4 s0 = {0.f, 0.f, 0.f, 0.f}, s1 = s0;
#pragma unroll
        for (int ks = 0; ks < 8; ++ks) { const int kb_ = ks * 64 + quad * 16;
            const bf16x8 a = ldfrag(L + QS, it * 16 + l15, 528, kb_);
            s0 = mfma16(a, ldfrag(L + KS, jt0 * 16 + l15, 528, kb_), s0);
            s1 = mfma16(a, ldfrag(L + KS, (jt0 + 1) * 16 + l15, 528, kb_), s1); }
        const float base = (float)(64 * (c - cp));
#pragma unroll
        for (int r = 0; r < 4; ++r) { const int i = it * 16 + quad * 4 + r; const int j0 = jt0 * 16 + l15, j1 = j0 + 16;
            const float w0 = (cp == c) ? exp2f(lg * fabsf((float)(i - j0))) : exp2f(lg * (base + (float)(i - j0)));
            const float w1 = (cp == c) ? exp2f(lg * fabsf((float)(i - j1))) : exp2f(lg * (base + (float)(i - j1)));
            ((LAS bf16_t*)(L + SSO + i * 144))[j0] = f2bf(s0[r] * w0);
            ((LAS bf16_t*)(L + SSO + i * 144))[j1] = f2bf(s1[r] * w1); }
        __syncthreads();
        if (cp < c) { RQ_KWRITE(); if (cp + 1 < c) RQ_KLOAD(cp + 2); }
#pragma unroll
        for (int ks = 0; ks < 2; ++ks) { const int kb_ = ks * 64 + quad * 16;
            bf16x8 sa[4], vb[4];
#pragma unroll
            for (int a = 0; a < 4; ++a) sa[a] = ldfrag(L + SSO, a * 16 + l15, 144, kb_);
#pragma unroll
            for (int t = 0; t < 4; ++t) vb[t] = ldfrag(L + VTC, (et0 + t) * 16 + l15, 144, kb_);
#pragma unroll
            for (int a = 0; a < 4; ++a)
#pragma unroll
                for (int t = 0; t < 4; ++t) acc[a][t] = mfma16(sa[a], vb[t], acc[a][t]); }
    }
#undef RQ_KLOAD
#undef RQ_VLOAD
#undef RQ_KWRITE
    LAS float* rsum = (LAS float*)(L + RSO);
#pragma unroll
    for (int a = 0; a < 4; ++a)
#pragma unroll
        for (int r = 0; r < 4; ++r) { float ss = 0.f;
#pragma unroll
            for (int t = 0; t < 4; ++t) ss += acc[a][t][r] * acc[a][t][r];
            ss += __shfl_xor(ss, 1); ss += __shfl_xor(ss, 2); ss += __shfl_xor(ss, 4); ss += __shfl_xor(ss, 8);
            if (l15 == 0) rsum[(a * 16 + quad * 4 + r) * 8 + w] = ss; }
    __syncthreads();
    const size_t tok0 = (size_t)b * SEQ + c * 64;
#pragma unroll
    for (int a = 0; a < 4; ++a)
#pragma unroll
        for (int r = 0; r < 4; ++r) { const int i = a * 16 + quad * 4 + r;
            const f32x4 p0 = *(LAS f32x4*)(rsum + i * 8), p1 = *(LAS f32x4*)(rsum + i * 8 + 4);
            const float rs = rsqrtf(((p0[0] + p0[1]) + (p0[2] + p0[3]) + (p1[0] + p1[1]) + (p1[2] + p1[3])) * (1.f / 512.f) + EPS);
#pragma unroll
            for (int t = 0; t < 4; ++t) { const int e = (et0 + t) * 16 + l15;
                const float g = bf2f(A1[(tok0 + i) * 8192 + 4096 + h * 512 + e]);
                const float sl = g / (1.f + __expf(-g));
                A2[(tok0 + i) * 3072 + h * 512 + e] = f2bf(sl * acc[a][t][r] * rs * rg[h * 512 + e]); } }
}

__device__ void retention_naive(int WAVE_S, LAS unsigned char* L, const bf16_t* __restrict__ A1, bf16_t* __restrict__ RETB, const bf16_t* __restrict__ KT, const bf16_t* __restrict__ VT) {
    LAS float* pw = (LAS float*)L;
    LAS float* qv = (LAS float*)(L + 16384);
    const int tid = opaque_tid();
#pragma unroll 1
    for (int item = blockIdx.x; item < T_TOK * 4; item += gridDim.x) {
        const int h = item & 3, tok = item >> 2, b = tok >> 12, n = tok & 4095, cn = n >> 6, nk = (cn + 1) * 64;
        const float lg = log2f(1.f - exp2f(-5.f - (float)h));
        __syncthreads();
        if (tid < 256) qv[tid] = bf2f(A1[(size_t)tok * 8192 + h * 256 + tid]);
        __syncthreads();
        for (int m = tid; m < nk; m += NTHR) {
            const bf16_t* kr = A1 + ((size_t)b * SEQ + m) * 8192 + 1024 + h * 256; float d = 0.f;
            if (NAIVE_SRC) { for (int k = 0; k < 256; ++k) d += bf2f(KT[((size_t)(b * 4 + h) * 256 + k) * SEQ + m]) * qv[k]; }
            else for (int k = 0; k < 256; k += 8) { float f[8]; unpack8(*(const u32x4*)(kr + k), f);
#pragma unroll
                for (int i = 0; i < 8; ++i) d += f[i] * qv[k + i]; }
            pw[m] = d * (((m >> 6) == cn) ? exp2f(lg * fabsf((float)(n - m))) : exp2f(lg * (float)(n - m)));
        }
        __syncthreads();
        float o = 0.f;
        const bf16_t* vc = A1 + (size_t)b * SEQ * 8192 + 2048 + h * 512 + tid;
        if (NAIVE_SRC) { const bf16_t* vt = VT + ((size_t)(b * 4 + h) * 512 + tid) * SEQ; for (int m = 0; m < nk; ++m) o += pw[m] * bf2f(vt[m]); }
        else for (int m = 0; m < nk; ++m) o += pw[m] * bf2f(vc[(size_t)m * 8192]);
        RETB[((size_t)((b * 4 + h) * 16 + (tid >> 5)) * SEQ + n) * 32 + (tid & 31)] = f2bf(o);
    }
}

__device__ void sg_item(int WAVE_S, LAS unsigned char* L, const bf16_t* __restrict__ A1, bf16_t* __restrict__ A2, const float* __restrict__ sgn, const float* __restrict__ sgw,
                        const float* __restrict__ sgb, int item) {
    const int g = item & 3, nb = (item >> 2) & 31, b = item >> 7;
    const int tid = opaque_tid(), lane = tid & 63, w = tid >> 6, l15 = lane & 15, quad = lane >> 4;
    const size_t tok0 = (size_t)b * SEQ + nb * 128;
    __syncthreads();
    {   const int c0 = (tid & 31) * 8; float gn[8];
#pragma unroll
        for (int i = 0; i < 8; ++i) gn[i] = sgn[g * 256 + c0 + i];
#pragma unroll 4
        for (int pass = 0; pass < 8; ++pass) { const int j = pass * 16 + (tid >> 5);
            float x[8]; unpack8(*(const u32x4*)(A1 + (tok0 + j) * 8192 + 7168 + g * 256 + c0), x);
            float ss = 0.f;
#pragma unroll
            for (int i = 0; i < 8; ++i) { x[i] = gelu_tanh(x[i]); ss += x[i] * x[i]; }
            ss += __shfl_xor(ss, 16); ss += __shfl_xor(ss, 8); ss += __shfl_xor(ss, 4); ss += __shfl_xor(ss, 2); ss += __shfl_xor(ss, 1);
            const float rs = rsqrtf(ss * (1.f / 256.f) + EPS);
#pragma unroll
            for (int i = 0; i < 8; ++i) ((LAS bf16_t*)(L + (c0 + i) * 272))[j] = f2bf(x[i] * rs * gn[i]); }
    }
    bf16x8 bw[4];
    {   const int i = w * 16 + l15; const float* wr = sgw + ((size_t)g * 128 + i) * 128;
#pragma unroll
        for (int ks = 0; ks < 4; ++ks) { const int j0 = ks * 32 + quad * 8; float f[8];
            const f32x4 a = *(const f32x4*)(wr + j0), c = *(const f32x4*)(wr + j0 + 4);
            const bool z = (i < 64) && (j0 >= 64);
#pragma unroll
            for (int q = 0; q < 4; ++q) { f[q] = z ? 0.f : a[q]; f[4 + q] = z ? 0.f : c[q]; }
            const u32x4 pw = pack8(f); bw[ks] = *(const bf16x8*)&pw; }
    }
    __syncthreads();
    const int ipos = w * 16 + l15;
    const float bias = sgb[g * 128 + ipos];
    const bf16_t* urow = A1 + (tok0 + ipos) * 8192 + 6144 + g * 256;
    bf16_t* orow = A2 + (tok0 + ipos) * 3072 + 2048 + g * 256;
    for (int ct = 0; ct < 16; ++ct) {
        f32x4 acc = {0.f, 0.f, 0.f, 0.f};
#pragma unroll
        for (int ks = 0; ks < 4; ++ks) acc = mfma16(ldfrag(L, ct * 16 + l15, 272, ks * 64 + quad * 16), bw[ks], acc);
        const int c = ct * 16 + quad * 4;
        const u32x2 uw = *(const u32x2*)(urow + c);
        const float u0 = gelu_tanh(bf_lo(uw.x)), u1 = gelu_tanh(bf_hi(uw.x)), u2 = gelu_tanh(bf_lo(uw.y)), u3 = gelu_tanh(bf_hi(uw.y));
        u32x2 ow; ow.x = cvt_pk_bf16(u0 * (acc[0] + bias), u1 * (acc[1] + bias)); ow.y = cvt_pk_bf16(u2 * (acc[2] + bias), u3 * (acc[3] + bias));
        if (ABL_SG) { ow.x = 0u; ow.y = 0u; }
        *(u32x2*)(orow + c) = ow;
    }
}

__device__ void ret_finalize(int WAVE_S, const bf16_t* __restrict__ A1, bf16_t* __restrict__ A2, const bf16_t* __restrict__ RETB, const float* __restrict__ rg) {
    const int tid_ = opaque_tid(); const int lane = tid_ & 63, wave = tid_ >> 6;
#pragma unroll 2
    for (int v = blockIdx.x * 8 + wave; v < T_TOK * 4; v += gridDim.x * 8) {
        const size_t tok = (size_t)(v >> 2); const int h = v & 3; const int col = h * 512 + lane * 8;
        float r[8], g[8];
        {   const int bb = (int)(tok >> 12), sidx = (int)(tok & 4095);
            unpack8(*(const u32x4*)(RETB + ((size_t)((bb * 4 + h) * 16 + (lane >> 2)) * SEQ + sidx) * 32 + (lane & 3) * 8), r); }
        unpack8(*(const u32x4*)(A1 + tok * 8192 + 4096 + col), g);
        float ss = 0.f;
#pragma unroll
        for (int i = 0; i < 8; ++i) ss += r[i] * r[i];
        ss = wave_sum(ss);
        const float rs = rsqrtf(ss * (1.f / 512.f) + EPS);
        const f32x4 g0 = *(const f32x4*)(rg + col), g1 = *(const f32x4*)(rg + col + 4);
#pragma unroll
        for (int i = 0; i < 8; ++i) { const float gi = (i < 4) ? g0[i & 3] : g1[i & 3]; const float sl = g[i] / (1.f + __expf(-g[i])); r[i] = sl * r[i] * rs * gi; }
        if (ABL_RET) { for (int i = 0; i < 8; ++i) r[i] = 0.f; }
        *(u32x4*)(A2 + tok * 3072 + col) = pack8(r);
    }
}

__device__ void xa_item(int WAVE_S, LAS unsigned char* L, const bf16_t* __restrict__ QX, const bf16_t* __restrict__ KVX, const bf16_t* __restrict__ XVT, bf16_t* __restrict__ AO, int item) {
    constexpr int KC = 0, PS = 69632;
    const int qb = item & 31, h = (item >> 5) & 3, b = item >> 7;
    const int tid = opaque_tid(), lane = tid & 63, w = tid >> 6, l15 = lane & 15, quad = lane >> 4;
    const size_t tokw = (size_t)b * SEQ + qb * 128 + w * 16;
    const bf16_t* qrow = QX + (tokw + l15) * 2048 + h * 512;
    const bf16_t* kbase = KVX + (size_t)b * 256 * 4096 + h * 512;
    const bf16_t* vbase = XVT + (size_t)(b * 4 + h) * 512 * 256;
    f32x4 acc[16];
#pragma unroll
    for (int k = 0; k < 16; ++k) acc[k] = (f32x4){0.f, 0.f, 0.f, 0.f};
    float qss = 0.f;
    u32x4 rg[8];
#define XA_KLOAD(dc_) do { _Pragma("unroll") for (int i = 0; i < 8; ++i) { const int idx = tid + NTHR * i; rg[i] = *(const u32x4*)(kbase + (size_t)(idx >> 4) * 4096 + (dc_) * 128 + (idx & 15) * 8); } } while (0)
#define XA_VLOAD(ec_) do { _Pragma("unroll") for (int i = 0; i < 8; ++i) { const int idx = tid + NTHR * i; rg[i] = *(const u32x4*)(vbase + (size_t)((ec_) * 128 + (idx >> 5)) * 256 + (idx & 31) * 8); } } while (0)
    XA_KLOAD(0);
#pragma unroll 1
    for (int dc = 0; dc < 4; ++dc) {
        __syncthreads();
#pragma unroll
        for (int i = 0; i < 8; ++i) { const int idx = tid + NTHR * i; *(LAS u32x4*)(L + KC + (idx >> 4) * 272 + (idx & 15) * 16) = rg[i]; }
        __syncthreads();
        if (dc < 3) XA_KLOAD(dc + 1); else XA_VLOAD(0);
#pragma unroll
        for (int ks = 0; ks < 4; ++ks) {
            const u32x4 qa = *(const u32x4*)(qrow + dc * 128 + ks * 32 + quad * 8);
            { float f[8]; unpack8(qa, f);
#pragma unroll
              for (int i = 0; i < 8; ++i) qss += f[i] * f[i]; }
            const bf16x8 a = *(const bf16x8*)&qa;
#pragma unroll
            for (int kt = 0; kt < 16; ++kt) acc[kt] = mfma16(a, ldfrag(L + KC, kt * 16 + l15, 272, ks * 64 + quad * 16), acc[kt]);
        }
    }
    qss += __shfl_xor(qss, 16); qss += __shfl_xor(qss, 32);
    const float rq = rsqrtf(qss * (1.f / 512.f) + EPS) * 0.044194173824159216f;
    float inv[4];
#pragma unroll
    for (int r = 0; r < 4; ++r) {
        const float sc = __shfl(rq, quad * 4 + r);
        float mx = -1e30f;
#pragma unroll
        for (int kt = 0; kt < 16; ++kt) { acc[kt][r] *= sc; mx = fmaxf(mx, acc[kt][r]); }
        mx = fmaxf(mx, __shfl_xor(mx, 1)); mx = fmaxf(mx, __shfl_xor(mx, 2)); mx = fmaxf(mx, __shfl_xor(mx, 4)); mx = fmaxf(mx, __shfl_xor(mx, 8));
        float sm = 0.f;
#pragma unroll
        for (int kt = 0; kt < 16; ++kt) { const float p = __expf(acc[kt][r] - mx); acc[kt][r] = p; sm += p; }
        sm += __shfl_xor(sm, 1); sm += __shfl_xor(sm, 2); sm += __shfl_xor(sm, 4); sm += __shfl_xor(sm, 8);
        inv[r] = 1.f / sm;
    }
    LAS unsigned char* Pw = L + PS + w * 8448;
#pragma unroll
    for (int kt = 0; kt < 16; ++kt)
#pragma unroll
        for (int r = 0; r < 4; ++r) ((LAS bf16_t*)(Pw + (quad * 4 + r) * 528))[kt * 16 + l15] = f2bf(acc[kt][r]);
    __syncthreads();
    bf16x8 pa[8];
#pragma unroll
    for (int ks = 0; ks < 8; ++ks) pa[ks] = ldfrag(Pw, l15, 528, ks * 64 + quad * 16);
    bf16_t* orow = AO + tokw * 2048 + h * 512;
#pragma unroll 1
    for (int ec = 0; ec < 4; ++ec) {
        __syncthreads();
#pragma unroll
        for (int i = 0; i < 8; ++i) { const int idx = tid + NTHR * i; *(LAS u32x4*)(L + KC + (idx >> 5) * 528 + (idx & 31) * 16) = rg[i]; }
        __syncthreads();
        if (ec < 3) XA_VLOAD(ec + 1);
#pragma unroll
        for (int et = 0; et < 8; ++et) {
            f32x4 o = {0.f, 0.f, 0.f, 0.f};
#pragma unroll
            for (int ks = 0; ks < 8; ++ks) o = mfma16(pa[ks], ldfrag(L + KC, et * 16 + l15, 528, ks * 64 + quad * 16), o);
#pragma unroll
            for (int r = 0; r < 4; ++r) orow[(size_t)(quad * 4 + r) * 2048 + ec * 128 + et * 16 + l15] = f2bf(o[r] * inv[r]);
        }
    }
#undef XA_KLOAD
#undef XA_VLOAD
    __syncthreads();
}

__device__ void diff_prep(int WAVE_S, bf16_t* A1, const int* __restrict__ pos, const float* __restrict__ qg, const float* __restrict__ kg) {
    const int gt = blockIdx.x * NTHR + opaque_tid();
    const int sub = gt & 7; const int i0 = sub * 8;
    float gq1[8], gq2[8], gk1[8], gk2[8];
#pragma unroll
    for (int i = 0; i < 8; ++i) { gq1[i] = qg[i0 + i]; gq2[i] = qg[64 + i0 + i]; gk1[i] = kg[i0 + i]; gk2[i] = kg[64 + i0 + i]; }
#pragma unroll 1
    for (int tok = gt >> 3; tok < T_TOK; tok += (gridDim.x * NTHR) >> 3) {
        const float p = (float)pos[tok];
        float cs[8], sn[8];
#pragma unroll
        for (int i = 0; i < 8; ++i) { const float inv = exp2f(-(float)(i0 + i) * (LOG2_THETA / 64.f)); fast_sincos(p * inv, &sn[i], &cs[i]); }
        bf16_t* row = A1 + (size_t)tok * 6144;
#pragma unroll 4
        for (int v = 0; v < 32; ++v) {
            bf16_t* x = row + (v < 16 ? 0 : 2048) + (v & 15) * 128;
            float x1[8], x2[8], y1[8], y2[8];
            unpack8(*(const u32x4*)(x + i0), x1); unpack8(*(const u32x4*)(x + 64 + i0), x2);
            float ss = 0.f;
#pragma unroll
            for (int i = 0; i < 8; ++i) ss += x1[i] * x1[i] + x2[i] * x2[i];
            ss += __shfl_xor(ss, 1); ss += __shfl_xor(ss, 2); ss += __shfl_xor(ss, 4);
            const float rs = rsqrtf(ss * (1.f / 128.f) + EPS);
#pragma unroll
            for (int i = 0; i < 8; ++i) { const float a = x1[i] * rs * (v < 16 ? gq1[i] : gk1[i]), c = x2[i] * rs * (v < 16 ? gq2[i] : gk2[i]);
                y1[i] = a * cs[i] - c * sn[i]; y2[i] = c * cs[i] + a * sn[i]; }
            *(u32x4*)(x + i0) = pack8(y1); *(u32x4*)(x + 64 + i0) = pack8(y2);
        }
    }
}

__device__ void diff_post(int WAVE_S, const bf16_t* __restrict__ P0, const bf16_t* __restrict__ P1, bf16_t* __restrict__ DO, const float* __restrict__ sg,
                          const float* __restrict__ lq1, const float* __restrict__ lk1, const float* __restrict__ lq2, const float* __restrict__ lk2) {
    const float lambda_init = 0.8f - 0.6f * 0.7408182206817179f;
    const int tid_ = opaque_tid(); const int lane = tid_ & 63;
    float d1 = lq1[lane] * lk1[lane] + lq1[lane + 64] * lk1[lane + 64], d2 = lq2[lane] * lk2[lane] + lq2[lane + 64] * lk2[lane + 64];
    d1 = wave_sum(d1); d2 = wave_sum(d2);
    const float lam = expf(d1) - expf(d2) + lambda_init;
    const int gt = blockIdx.x * NTHR + tid_;
    const int sub = gt & 31; float g[8];
#pragma unroll
    for (int i = 0; i < 8; ++i) g[i] = sg[sub * 8 + i] * (1.f - lambda_init);
    const size_t nvec = (size_t)T_TOK * 8;
#pragma unroll 2
    for (size_t v = gt >> 5; v < nvec; v += (size_t)(gridDim.x * NTHR) >> 5) {
        const size_t off = v * 256 + sub * 8;
        float a[8], c[8]; unpack8(*(const u32x4*)(P0 + off), a); unpack8(*(const u32x4*)(P1 + off), c);
        float ss = 0.f;
#pragma unroll
        for (int i = 0; i < 8; ++i) { a[i] = a[i] - lam * c[i]; ss += a[i] * a[i]; }
        ss += __shfl_xor(ss, 16); ss += __shfl_xor(ss, 8); ss += __shfl_xor(ss, 4); ss += __shfl_xor(ss, 2); ss += __shfl_xor(ss, 1);
        const float rs = rsqrtf(ss * (1.f / 256.f) + EPS);
#pragma unroll
        for (int i = 0; i < 8; ++i) a[i] = a[i] * rs * g[i];
        *(u32x4*)(DO + off) = pack8(a);
    }
}


__device__ __forceinline__ void chk_report(unsigned* flag, float val, float got) {
    const float rel = fabsf(val - got) / (fabsf(val) + 0.25f);
    atomicMax(flag, __float_as_uint(rel));
    if (rel > 0.05f) atomicAdd(flag + 1, 1u);
}
__device__ void check_ret(int WAVE_S, const bf16_t* A1, const bf16_t* A2, unsigned* flag) {
    const int tid = opaque_tid(), lane = tid & 63, wave = tid >> 6;
    const int s = blockIdx.x * 8 + wave;
    const int b = s & 3, h = (s >> 2) & 3, n = (s * 977 + 13) & 4095, e = (s * 131) & 511;
    const float lg = log2f(1.f - exp2f(-5.f - (float)h));
    const bf16_t* qrow = A1 + ((size_t)b * SEQ + n) * 8192 + h * 256;
    const int cn = n >> 6; float accA = 0.f, accB = 0.f;
    for (int m = lane; m < (cn + 1) * 64; m += 64) {
        const bf16_t* krow = A1 + ((size_t)b * SEQ + m) * 8192 + 1024 + h * 256;
        float d = 0.f;
        for (int k = 0; k < 256; ++k) d += bf2f(qrow[k]) * bf2f(krow[k]);
        const float v = bf2f(A1[((size_t)b * SEQ + m) * 8192 + 2048 + h * 512 + e]);
        if ((m >> 6) == cn) accA += exp2f(lg * fabsf((float)(n - m))) * d * v; else accB += exp2f(lg * (float)(n - m)) * d * v;
    }
    accA = wave_sum(accA); accB = wave_sum(accB);
    if (lane == 0) {
        const float got = bf2f(A2[((size_t)b * SEQ + n) * 3072 + h * 512 + e]);
        if (CHKALT == 3) { const float val = (RETPART == 1) ? accA : (RETPART == 2) ? accB : accA + accB; const float rel = fabsf(val - got) / (fabsf(val) + 0.25f); if (rel > 0.05f) atomicAdd(flag + 1, 1u); }
        if (CHKALT == 2) { const float val = accA + exp2f(lg * 64.f) * accB; const float rel = fabsf(val - got) / (fabsf(val) + 0.25f); if (rel > 0.05f) atomicAdd(flag + 1, 1u); }
        if (CHKALT == 1 && fabsf(accA) > 2.f) { atomicAdd((float*)(flag + 2), (got - accB) / accA); atomicAdd(flag + 1, 1u); }
    }
}
__device__ void check_sg(int WAVE_S, const bf16_t* A1, const bf16_t* A2, const float* sgn, const float* sgw, const float* sgb, unsigned* flag) {
    const int tid = opaque_tid(), lane = tid & 63, wave = tid >> 6;
    const int s = blockIdx.x * 8 + wave;
    const int b = s & 3, g = (s >> 2) & 3, n = (s * 977 + 13) & 4095, c = (s * 131) & 255;
    const int i = n & 127; const size_t tok0 = (size_t)b * SEQ + (n & ~127);
    float acc = 0.f;
    for (int j = lane; j < 128; j += 64) {
        const bf16_t* vr = A1 + (tok0 + j) * 8192 + 7168 + g * 256; float ss = 0.f;
        for (int k = 0; k < 256; ++k) { const float x = gelu_tanh(bf2f(vr[k])); ss += x * x; }
        const float vn = gelu_tanh(bf2f(vr[c])) * rsqrtf(ss * (1.f / 256.f) + EPS) * sgn[g * 256 + c];
        const bool keep = (j >> 6) <= (i >> 6);
        acc += keep ? sgw[((size_t)g * 128 + i) * 128 + j] * vn : 0.f;
    }
    acc = wave_sum(acc);
    const float u = gelu_tanh(bf2f(A1[(tok0 + i) * 8192 + 6144 + g * 256 + c]));
    if (lane == 0) chk_report(flag, u * (acc + sgb[g * 128 + i]), bf2f(A2[(tok0 + i) * 3072 + 2048 + g * 256 + c]));
}
__device__ void check_xa(int WAVE_S, const bf16_t* QX, const bf16_t* KVX, const bf16_t* XVT, const bf16_t* AO, unsigned* flag) {
    const int tid = opaque_tid(), lane = tid & 63, wave = tid >> 6;
    const int s = blockIdx.x * 8 + wave;
    const int b = s & 3, h = (s >> 2) & 3, n = (s * 977 + 13) & 4095, e = (s * 131) & 511;
    const bf16_t* q = QX + ((size_t)b * SEQ + n) * 2048 + h * 512;
    float qs = 0.f; for (int k = 0; k < 512; ++k) qs += bf2f(q[k]) * bf2f(q[k]);
    const float rq = rsqrtf(qs * (1.f / 512.f) + EPS) * 0.044194173824159216f;
    float sc[4], mx = -1e30f;
    for (int t = 0; t < 4; ++t) { const int key = lane + 64 * t; const bf16_t* kr = KVX + ((size_t)b * 256 + key) * 4096 + h * 512; float d = 0.f;
        for (int k = 0; k < 512; ++k) d += bf2f(q[k]) * bf2f(kr[k]);
        sc[t] = d * rq; mx = fmaxf(mx, sc[t]); }
    for (int o = 32; o; o >>= 1) mx = fmaxf(mx, __shfl_xor(mx, o));
    float sm = 0.f, ov = 0.f;
    for (int t = 0; t < 4; ++t) { const int key = lane + 64 * t; const float p = __expf(sc[t] - mx); sm += p; ov += p * bf2f(XVT[((size_t)(b * 4 + h) * 512 + e) * 256 + key]); }
    sm = wave_sum(sm); ov = wave_sum(ov);
    if (lane == 0) chk_report(flag, ov / sm, bf2f(AO[((size_t)b * SEQ + n) * 2048 + h * 512 + e]));
}
__device__ void check_diff(int WAVE_S, const bf16_t* A1, const bf16_t* P0, const bf16_t* P1, unsigned* flag) {
    const int tid = opaque_tid(), lane = tid & 63, wave = tid >> 6;
    const int s = blockIdx.x * 8 + wave;
    const int b = s & 3, h = (s >> 2) & 7, m = (s >> 5) & 1, n = (s * 977 + 13) & 4095, e = (s * 131) & 255;
    const bf16_t* q = A1 + ((size_t)b * SEQ + n) * 6144 + h * 256 + m * 128;
    const int nk = ((n >> 6) + 1) * 64;
    float mx = -1e30f;
    for (int key = lane; key < nk; key += 64) { const bf16_t* kr = A1 + ((size_t)b * SEQ + key) * 6144 + 2048 + h * 256 + m * 128; float d = 0.f;
        for (int k = 0; k < 128; ++k) d += bf2f(q[k]) * bf2f(kr[k]);
        mx = fmaxf(mx, d * 0.088388347648318440f); }
    for (int o = 32; o; o >>= 1) mx = fmaxf(mx, __shfl_xor(mx, o));
    float sm = 0.f, ov = 0.f;
    for (int key = lane; key < nk; key += 64) { const bf16_t* kr = A1 + ((size_t)b * SEQ + key) * 6144 + 2048 + h * 256 + m * 128; float d = 0.f;
        for (int k = 0; k < 128; ++k) d += bf2f(q[k]) * bf2f(kr[k]);
        const float p = __expf(d * 0.088388347648318440f - mx); sm += p; ov += p * bf2f(A1[((size_t)b * SEQ + key) * 6144 + 4096 + h * 256 + e]); }
    sm = wave_sum(sm); ov = wave_sum(ov);
    if (lane == 0) chk_report(flag, ov / sm, bf2f((m ? P1 : P0)[((size_t)b * SEQ + n) * 2048 + h * 256 + e]));
}


__device__ __forceinline__ void grid_barrier(int WAVE_S, unsigned* bar, unsigned k  ) {
    asm volatile("s_waitcnt vmcnt(0)" ::: "memory");
    __syncthreads();
    if (opaque_tid() == 0) {
        __builtin_amdgcn_fence(__ATOMIC_RELEASE, "agent");
        const unsigned x = blockIdx.x & 7u;
        const unsigned old = __hip_atomic_fetch_add(bar + 64 * x, 1u, __ATOMIC_RELAXED, __HIP_MEMORY_SCOPE_AGENT);
        if (old + 1u == 32u * k) {
            const unsigned old2 = __hip_atomic_fetch_add(bar + 64 * 8, 1u, __ATOMIC_RELAXED, __HIP_MEMORY_SCOPE_AGENT);
            if (old2 + 1u == 8u * k) __hip_atomic_store(bar + 64 * 9, k, __ATOMIC_RELAXED, __HIP_MEMORY_SCOPE_AGENT);
        }
        while (__hip_atomic_load(bar + 64 * 9, __ATOMIC_RELAXED, __HIP_MEMORY_SCOPE_AGENT) < k) __builtin_amdgcn_s_sleep(1);
        __builtin_amdgcn_fence(__ATOMIC_ACQUIRE, "agent");
    }
    __syncthreads();
}

#ifndef EN_CVT_WEIGHT
#define EN_CVT_WEIGHT 1
#endif
#ifndef EN_RMSNORM_ROWS
#define EN_RMSNORM_ROWS 1
#endif
#ifndef EN_L0_PREP_ITEM
#define EN_L0_PREP_ITEM 1
#endif
#ifndef EN_XA_PREP_ITEM
#define EN_XA_PREP_ITEM 1
#endif
#ifndef EN_RET_FINALIZE
#define EN_RET_FINALIZE 1
#endif
#ifndef EN_DIFF_PREP
#define EN_DIFF_PREP 1
#endif
#ifndef EN_DIFF_POST
#define EN_DIFF_POST 1
#endif
#ifndef EN_GEMM
#define EN_GEMM 1
#endif
#ifndef EN_ATT
#define EN_ATT 1
#endif
#ifndef EN_RET
#define EN_RET 1
#endif
#ifndef EN_SG
#define EN_SG 1
#endif
#ifndef EN_XA
#define EN_XA 1
#endif
#ifndef EN_MISC
#define EN_MISC 1
#endif
__global__ void __launch_bounds__(NTHR, 2) mk(Params p) {
    extern __shared__ __attribute__((aligned(16))) unsigned char lds_raw[];
    LAS unsigned char* L = (LAS unsigned char*)lds_raw;
    const int WAVE_S = __builtin_amdgcn_readfirstlane((int)(threadIdx.x >> 6));
    cg::grid_group grid = cg::this_grid();
    unsigned char* ws = p.ws;
#define X (p.out)
#define W ((bf16_t*)(p.ws + OFF_W))
#define A1 ((bf16_t*)(p.ws + OFF_A1))
#define A2 ((bf16_t*)(p.ws + OFF_A2))
#define A3 ((bf16_t*)(p.ws + OFF_A3))
#define KVX ((bf16_t*)(p.ws + OFF_KVX))
#define XVT ((bf16_t*)(p.ws + OFF_XVT))
#define MEMN ((bf16_t*)(p.ws + OFF_MEMN))
#define SSQ ((float*)(p.ws + OFF_SSQ))
#define XS ((bf16_t*)(p.ws + OFF_XS))
#define W2KV ((bf16_t*)(p.ws + OFF_W2KV))
#define KVX2 ((bf16_t*)(p.ws + OFF_KVX2))
#define XVT2 ((bf16_t*)(p.ws + OFF_XVT2))
#define MEMN2 ((bf16_t*)(p.ws + OFF_MEMN2))
#define KT ((bf16_t*)(p.ws + OFF_KT))
#define RETB ((bf16_t*)(p.ws + OFF_RET))
    const int G = gridDim.x, bid = blockIdx.x;
    const int lo = p.ph_lo, hi = p.ph_hi;
    int ph = 0; unsigned nbar = 0;
#define PHASE_BEGIN if (lo <= ph && ph < hi) {
#define PHASE_END   if (ph + 1 < hi) { if (ph == lo) grid.sync(); else { ++nbar; grid_barrier(WAVE_S, (unsigned*)(p.ws + OFF_SSQ), nbar); } } } ++ph;
#define INF(k) ((const float*)p.in[k])

#define SSQK(k) ((float*)(p.ws + OFF_SSQ + 4096) + (size_t)(k) * T_TOK)
    for (int li = 0; li < 2; ++li) {
#define n_xa (INF(4) + li * 2048)
#define n_mem (INF(5) + li * 2048)
#define n_ffn (INF(6) + li * 2048)
#define n_mix (INF(3) + li * 2048)
#define wXQ (li ? W1_XQ : W0_XQ)
#define wXKV (li ? W1_XKV : W0_XKV)
#define wXO (li ? W1_XO : W0_XO)
#define wF1 (li ? W1_F1 : W0_F1)
#define wF2 (li ? W1_F2 : W0_F2)
        if (li == 0) {
            PHASE_BEGIN
                cvt_weight(WAVE_S, L, INF(23), W + W0_XKV, 2048, 4096);
                cvt_weight(WAVE_S, L, INF(23) + (size_t)2048 * 4096, W2KV, 2048, 4096);
                rmsnorm_rows(WAVE_S, INF(1), INF(5), MEMN, nullptr, 1024);
                rmsnorm_rows(WAVE_S, INF(1), INF(5) + 2048, MEMN2, nullptr, 1024);
            PHASE_END
            PHASE_BEGIN
                if (bid < 64) pg8::run_gemm(WAVE_S, L, MEMN, W + W0_XKV, 1024, 4096, 2048, pg8::EpiBf16<0>{KVX, 4096, nullptr}, bid);
                else if (bid < 128) pg8::run_gemm(WAVE_S, L, MEMN2, W2KV, 1024, 4096, 2048, pg8::EpiBf16<0>{KVX2, 4096, nullptr}, bid - 64);
                else { cvt_weight(WAVE_S, L, INF(22), W + W0_XQ, 2048, 2048, n_xa, bid - 128, 128);
                       cvt_weight(WAVE_S, L, INF(26), W + W0_XO, 2048, 2048, nullptr, bid - 128, 128);
                       cvt_weight(WAVE_S, L, INF(12), W + W0_OUT, 3072, 2048, nullptr, bid - 128, 128); }
                cvt_weight(WAVE_S, L, INF(7), W + W0_IN, 2048, 8192);
                cvt_weight(WAVE_S, L, INF(27), W + W0_F1, 2048, 8192, n_ffn);
                cvt_weight(WAVE_S, L, INF(28), W + W0_F2, 8192, 2048);
                rmsnorm_rows(WAVE_S, INF(0), n_mix, A2, nullptr, T_TOK);
            PHASE_END
        } else {
            PHASE_BEGIN
                cvt_weight(WAVE_S, L, INF(13), W + W1_QKV, 2048, 6144, n_mix); cvt_weight(WAVE_S, L, INF(21), W + W1_O, 2048, 2048);
                cvt_weight(WAVE_S, L, INF(22) + (size_t)2048 * 2048, W + W1_XQ, 2048, 2048, n_xa);
                cvt_weight(WAVE_S, L, INF(26) + (size_t)2048 * 2048, W + W1_XO, 2048, 2048);
                cvt_weight(WAVE_S, L, INF(27) + (size_t)2048 * 8192, W + W1_F1, 2048, 8192, n_ffn);
                cvt_weight(WAVE_S, L, INF(28) + (size_t)8192 * 2048, W + W1_F2, 8192, 2048);
            PHASE_END
        }
        if (li == 0) {
            PHASE_BEGIN
                pg8::run_gemm(WAVE_S, L, A2, W + W0_IN, T_TOK, 8192, 2048, pg8::EpiBf16<0>{A1, 8192, nullptr});
            PHASE_END
            PHASE_BEGIN
                for (int it = bid; it < 1024; it += G) l0_prep_item(WAVE_S, L, A1, (const int*)p.in[2], KT, A3, it);
                for (int it = bid; it < 128; it += G) { if (it < 64) xa_prep_item(WAVE_S, L, KVX, XVT, INF(25), INF(24), it); else xa_prep_item(WAVE_S, L, KVX2, XVT2, INF(25) + 512, INF(24) + 512, it - 64); }
            PHASE_END
            PHASE_BEGIN
                {   const int gq = bid >> 4, bhq = bid & 15;
                    for (int k = 0; k < 4; ++k) { const int cq = (k & 1) ? (63 - 16 * k - 15 + gq) : (63 - 16 * k - gq); retention_quad_item(WAVE_S, L, A1, A3, A2, INF(8), bhq, cq); } }
                for (int it = bid; it < 512; it += G) sg_item(WAVE_S, L, A1, A2, INF(9), INF(10), INF(11), it);
            PHASE_END
            PHASE_BEGIN
                pg8::run_gemm(WAVE_S, L, A2, W + W0_OUT, T_TOK, 2048, 3072, pg8::EpiStream<0>{INF(0), XS, SSQK(0), nullptr, 2048});
            PHASE_END
        } else {
            PHASE_BEGIN
                pg8::run_gemm(WAVE_S, L, XS, W + W1_QKV, T_TOK, 6144, 2048, pg8::EpiBf16<0>{A1, 6144, SSQK(2)});
            PHASE_END
            PHASE_BEGIN
                diff_prep(WAVE_S, A1, (const int*)p.in[2], INF(14), INF(15));
            PHASE_END
            PHASE_BEGIN
                for (int k = 0; k < 2048 / 256; ++k) {
                    const int i = k * G + bid; if (i >= 2048) break;
                    const int half = (bid >= 128) ? 1 : 0; const int pick = (k & 1) ? (1 - half) : half;
                    const int qbl = 15 - (2 * k + pick); const int rest = bid & 127;
                    const int vh = rest & 1, m = (rest >> 1) & 1, h = (rest >> 2) & 7, b = rest >> 5;
                    const bf16_t* base = A1 + (size_t)b * SEQ * 6144;
                    bf16_t* PO = m ? A3 : (A1 + (size_t)T_TOK * 6144);
                    __syncthreads();
                    att::attn_body(WAVE_S, base + (size_t)qbl * 256 * 6144 + h * 256 + m * 128, base + 2048 + h * 256 + m * 128, base + 4096 + h * 256 + vh * 128,
                                   PO + ((size_t)b * SEQ + qbl * 256) * 2048 + h * 256 + vh * 128, (qbl + 1) * 256, (char*)lds_raw);
                }
                __syncthreads();
            PHASE_END
            PHASE_BEGIN
                diff_post(WAVE_S, A1 + (size_t)T_TOK * 6144, A3, A2, INF(20), INF(16), INF(17), INF(18), INF(19));
            PHASE_END
            PHASE_BEGIN
                pg8::run_gemm(WAVE_S, L, A2, W + W1_O, T_TOK, 2048, 2048, pg8::EpiStream<1>{nullptr, XS, SSQK(3), nullptr, 2048});
            PHASE_END
        }
        PHASE_BEGIN
            pg8::run_gemm(WAVE_S, L, XS, W + wXQ, T_TOK, 2048, 2048, pg8::EpiBf16<0>{A3, 2048, SSQK(li ? 3 : 0)});
        PHASE_END
        PHASE_BEGIN
            for (int it = bid; it < 512; it += G) xa_item(WAVE_S, L, A3, li ? KVX2 : KVX, li ? XVT2 : XVT, A2, it);
        PHASE_END
        PHASE_BEGIN
            pg8::run_gemm(WAVE_S, L, A2, W + wXO, T_TOK, 2048, 2048, pg8::EpiStream<1>{nullptr, XS, SSQK(li ? 4 : 1), nullptr, 2048});
        PHASE_END
        PHASE_BEGIN
            pg8::run_gemm(WAVE_S, L, XS, W + wF1, T_TOK, 8192, 2048, pg8::EpiBf16<1>{A1, 8192, SSQK(li ? 4 : 1)});
        PHASE_END
        PHASE_BEGIN
            if (li == 0) pg8::run_gemm(WAVE_S, L, A1, W + wF2, T_TOK, 2048, 8192, pg8::EpiStream<1>{nullptr, XS, SSQK(2), nullptr, 2048});
            else pg8::run_gemm(WAVE_S, L, A1, W + wF2, T_TOK, 2048, 8192, pg8::EpiStream<2>{nullptr, XS, nullptr, X, 2048});
        PHASE_END
    }
}

#undef SSQK
#undef XS
#undef W2KV
#undef KVX2
#undef XVT2
#undef MEMN2
#undef W
#undef A1
#undef A2
#undef A3
#undef KVX
#undef XVT
#undef MEMN
#undef KT
#undef RETB
#undef SSQ
#undef X
#undef n_xa
#undef n_mem
#undef n_ffn
#undef n_mix
#undef wXQ
#undef wXKV
#undef wXO
#undef wF1
#undef wF2
__global__ void __launch_bounds__(NTHR) chk_kernel(Params p) {
    const int WAVE_S = (int)(threadIdx.x >> 6);
    unsigned char* ws = p.ws;
    bf16_t* A1 = (bf16_t*)(ws + OFF_A1); bf16_t* A2 = (bf16_t*)(ws + OFF_A2); bf16_t* A3 = (bf16_t*)(ws + OFF_A3);
    bf16_t* KVX = (bf16_t*)(ws + OFF_KVX); bf16_t* XVT = (bf16_t*)(ws + OFF_XVT); unsigned* flag = (unsigned*)(ws + OFF_SSQ + 4096);
    if (CHK == 1) check_ret(WAVE_S, A1, A2, flag);
    if (CHK == 2) check_sg(WAVE_S, A1, A2, (const float*)p.in[9], (const float*)p.in[10], (const float*)p.in[11], flag);
    if (CHK == 3) check_xa(WAVE_S, A3, KVX, XVT, A2, flag);
    if (CHK == 4) check_diff(WAVE_S, A1, A1 + (size_t)T_TOK * 6144, A3, flag);
}
__global__ void chk_final(float* X, unsigned* flag) { const unsigned c = atomicAdd(flag + 1, 0u); X[0] = 1e5f * (float)((c + 32u) >> 6); }
__global__ void chk_zero(unsigned* flag) { if (threadIdx.x < 8) atomicExch(flag + threadIdx.x, 0u); }

#ifndef MK_PER_PHASE
#define MK_PER_PHASE 0
#endif
constexpr int N_PHASES = 22;
extern "C" void kernel_launch(void* const* d_in, const int* in_sizes, int n_in, void* d_out, int out_size, void* d_ws, size_t ws_size, hipStream_t stream) {
    static int grid = 0;
    if (grid == 0) {
        if (n_in != 29 || out_size != T_TOK * DM || ws_size < WS_END) { fprintf(stderr, "kernel_launch: unexpected shapes n_in %d out %d ws %zu (need %zu)\n", n_in, out_size, ws_size, (size_t)WS_END); grid = -1; return; }
        int dev = 0, cus = 0, per_cu = 0;
        hipGetDevice(&dev); hipDeviceGetAttribute(&cus, hipDeviceAttributeMultiprocessorCount, dev);
        if (hipFuncSetAttribute((const void*)mk, hipFuncAttributeMaxDynamicSharedMemorySize, LDS_BYTES) != hipSuccess) { fprintf(stderr, "kernel_launch: hipFuncSetAttribute failed\n"); grid = -1; return; }
        if (hipOccupancyMaxActiveBlocksPerMultiprocessor(&per_cu, (const void*)mk, NTHR, LDS_BYTES) != hipSuccess || per_cu < 1) { fprintf(stderr, "kernel_launch: occupancy query says %d\n", per_cu); per_cu = 1; }
        (void)hipGetLastError();
        grid = cus * 1;
        if (grid > 256) grid = 256;
        if (grid != 256) { fprintf(stderr, "kernel_launch: this kernel is laid out for 256 workgroups (one per CU of a 256-CU device); found %d CUs\n", cus); grid = -1; return; }
    }
    if (grid < 0) return;
    Params p{};
    for (int i = 0; i < 29; ++i) p.in[i] = d_in[i];
    p.out = (float*)d_out; p.ws = (unsigned char*)d_ws;
#if MK_PER_PHASE
    for (int k = 0; k < N_PHASES; ++k) { p.ph_lo = k; p.ph_hi = k + 1; hipLaunchKernelGGL(mk, dim3(grid), dim3(NTHR), LDS_BYTES, stream, p);
        if (CHK && k == 0) hipLaunchKernelGGL(chk_zero, dim3(1), dim3(64), 0, stream, (unsigned*)((char*)d_ws + OFF_SSQ + 4096));
        if (((CHK == 1 || CHK == 2) && k == 3) || (CHK == 3 && k == 8) || (CHK == 4 && k == 16)) hipLaunchKernelGGL(chk_kernel, dim3(256), dim3(NTHR), 0, stream, p); }
    if (CHK) hipLaunchKernelGGL(chk_final, dim3(1), dim3(1), 0, stream, (float*)d_out, (unsigned*)((char*)d_ws + OFF_SSQ + 4096));
#else
    p.ph_lo = 0; p.ph_hi = N_PHASES;
    (void)hipMemsetAsync((char*)d_ws + OFF_SSQ, 0, 4096 + 5 * T_TOK * 4, stream);
    void* args[] = {&p};
    hipError_t e = hipLaunchCooperativeKernel((const void*)mk, dim3(grid), dim3(NTHR), args, LDS_BYTES, stream);
    if (e != hipSuccess) fprintf(stderr, "cooperative launch failed: %s (grid %d)\n", hipGetErrorString(e), grid);
#endif
}
```
